# Optimizing an MI355X kernel written in HIP

```python
import math
import jax, jax.numpy as jnp
from jax import lax
import numpy as np

D_MODEL = 1024
BATCH = 8
SEQ = 2048
DEPTH = 4
DEC_BATCH = 2
DEC_SEQ = 8192
PAST_LEN = 128

GRID_W = 64
Q_BLOCK = 128
EPS = 1e-6
DA_HEADS = 8
DA_HEAD_DIM = 64
DA_V_DIM = 2 * DA_HEAD_DIM
NA_HEADS = 16
NA_HEAD_DIM = 64
NA_ROWS_MAX = 8
NA_COLS = 16
GQ_HEADS = 8
GQ_KV_HEADS = 2
GQ_HEAD_DIM = 128
ROPE_THETA = 10000.0
D_FF = 4 * D_MODEL
PLE_DIM = 256
N_BRANCH = 3

DA_Q = DA_HEADS * 2 * DA_HEAD_DIM
DA_K = DA_HEADS * 2 * DA_HEAD_DIM
DA_V = DA_HEADS * DA_V_DIM
NA_W = NA_HEADS * NA_HEAD_DIM
GQ_Q = GQ_HEADS * GQ_HEAD_DIM
GQ_KV = GQ_KV_HEADS * GQ_HEAD_DIM
GATE_W = N_BRANCH * D_MODEL
IN_SIZES = (DA_Q, DA_K, DA_V, NA_W, NA_W, NA_W, GQ_Q, GQ_KV, GQ_KV, GATE_W)
IN_W = DA_Q + DA_K + DA_V + 3 * NA_W + GQ_Q + 2 * GQ_KV + GATE_W

kernel_name = "hybrid_gated_parallel_encoder"


def rmsnorm(x, g):
    xf = x.astype(jnp.float32)
    y = xf * lax.rsqrt(jnp.mean(xf * xf, axis=-1, keepdims=True) + EPS)
    return (y * g.astype(jnp.float32)).astype(x.dtype)


def split_cols(z):
    outs = []
    off = 0
    for n in IN_SIZES:
        outs.append(z[..., off:off + n])
        off += n
    return outs


def diff_attention(q, k, v, lam):
    B, S, H = q.shape[0], q.shape[1], q.shape[2]
    nb = S // Q_BLOCK
    scale = DA_HEAD_DIM ** -0.5
    slopes = jnp.exp2(-8.0 * jnp.arange(1, H + 1, dtype=jnp.float32) / H)
    pos = jnp.arange(S)
    qb = q.reshape(B, nb, Q_BLOCK, H, 2, DA_HEAD_DIM).transpose(1, 0, 2, 3, 4, 5)

    def block(args):
        qblk, start = args
        s = jnp.einsum('bqhmd,bkhmd->bmhqk', qblk, k).astype(jnp.float32) * scale
        qpos = start + jnp.arange(Q_BLOCK)
        dist = jnp.abs(qpos[:, None] - pos[None, :]).astype(jnp.float32)
        s = s - slopes[:, None, None] * dist
        p = jax.nn.softmax(s, axis=-1)
        a = p[:, 0] - lam * p[:, 1]
        return jnp.einsum('bhqk,bkhe->bqhe', a.astype(v.dtype), v)

    out = lax.map(block, (qb, jnp.arange(nb) * Q_BLOCK))
    return out.transpose(1, 0, 2, 3, 4).reshape(B, S, H, DA_V_DIM)


def neighbourhood_attention(q, k, v, rpb):
    B, S, H, d = q.shape
    rows = S // GRID_W
    kr = min(NA_ROWS_MAX, rows)
    scale = NA_HEAD_DIM ** -0.5
    r = jnp.arange(rows)
    row_start = jnp.clip(r - kr // 2, 0, rows - kr)
    c = jnp.arange(GRID_W)
    col_start = jnp.clip(c - NA_COLS // 2, 0, GRID_W - NA_COLS)
    in_win = (c[None, :] >= col_start[:, None]) & (c[None, :] < col_start[:, None] + NA_COLS)
    dc = jnp.clip(c[None, :] - c[:, None], -(NA_COLS - 1), NA_COLS - 1) + (NA_COLS - 1)
    qg = q.reshape(B, rows, GRID_W, H, d).transpose(1, 0, 2, 3, 4)
    kg = k.reshape(B, rows, GRID_W, H, d)
    vg = v.reshape(B, rows, GRID_W, H, d)

    def row_block(args):
        q_row, r0, start = args
        k_rows = lax.dynamic_slice_in_dim(kg, start, kr, axis=1)
        v_rows = lax.dynamic_slice_in_dim(vg, start, kr, axis=1)
        dr = start + jnp.arange(kr) - r0 + (NA_ROWS_MAX - 1)
        bias = rpb[:, dr[:, None, None], dc[None, :, :]].transpose(0, 2, 1, 3)
        s = jnp.einsum('bqhd,bikhd->bhqik', q_row, k_rows).astype(jnp.float32) * scale
        s = s + bias[None].astype(jnp.float32)
        s = jnp.where(in_win[:, None, :], s, -jnp.inf)
        p = jax.nn.softmax(s.reshape(B, H, GRID_W, kr * GRID_W), axis=-1).reshape(s.shape)
        return jnp.einsum('bhqik,bikhd->bqhd', p.astype(v.dtype), v_rows)

    out = lax.map(row_block, (qg, r, row_start))
    return out.transpose(1, 0, 2, 3, 4).reshape(B, S, H, d)


def axial_rope_tables(S):
    t = jnp.arange(S)
    row = (t // GRID_W).astype(jnp.float32)
    col = (t % GRID_W).astype(jnp.float32)
    half = GQ_HEAD_DIM // 2
    freqs = ROPE_THETA ** (-jnp.arange(0, half, 2, dtype=jnp.float32) / half)
    ang = jnp.concatenate([row[:, None] * freqs, col[:, None] * freqs], axis=-1)
    return jnp.cos(ang), jnp.sin(ang)


def apply_rope(x, cos, sin):
    x2 = x.astype(jnp.float32).reshape(x.shape[:-1] + (x.shape[-1] // 2, 2))
    x0, x1 = x2[..., 0], x2[..., 1]
    c = cos[None, :, None, :]
    s = sin[None, :, None, :]
    out = jnp.stack([x0 * c - x1 * s, x0 * s + x1 * c], axis=-1)
    return out.reshape(x.shape).astype(x.dtype)


def gqa_attention(q, k, v):
    B, S = q.shape[0], q.shape[1]
    G = GQ_HEADS // GQ_KV_HEADS
    nb = S // Q_BLOCK
    scale = GQ_HEAD_DIM ** -0.5
    qb = q.reshape(B, nb, Q_BLOCK, GQ_KV_HEADS, G, GQ_HEAD_DIM).transpose(1, 0, 2, 3, 4, 5)

    def block(qblk):
        s = jnp.einsum('bqngd,bknd->bngqk', qblk, k).astype(jnp.float32) * scale
        p = jax.nn.softmax(s, axis=-1)
        return jnp.einsum('bngqk,bknd->bqngd', p.astype(v.dtype), v)

    out = lax.map(block, qb)
    return out.transpose(1, 0, 2, 3, 4, 5).reshape(B, S, GQ_Q)


def run_trunk(x, ple, w_in, da_lambda, da_norm, na_rpb, gq_q_norm, gq_k_norm,
              w_br_a, w_br_b, w_br_c, w_o, g_pre_mix, g_post_mix, g_pre_mlp, g_post_mlp,
              w_up, w_down, w_ple, w_ple_gate, g_ple):
    B, S = x.shape[0], x.shape[1]
    cos, sin = axial_rope_tables(S)
    h = x
    for i in range(DEPTH):
        lambda_init = 0.8 - 0.6 * math.exp(-0.3 * i)
        u = rmsnorm(h, g_pre_mix[i])
        z = u @ w_in[i]
        qa, ka, va, qn, kn, vn, qc, kc, vc, gz = split_cols(z)
        lq1, lk1, lq2, lk2 = (da_lambda[i, j].astype(jnp.float32) for j in range(4))
        lam = jnp.exp(jnp.sum(lq1 * lk1)) - jnp.exp(jnp.sum(lq2 * lk2)) + lambda_init
        oa = diff_attention(qa.reshape(B, S, DA_HEADS, 2, DA_HEAD_DIM),
                            ka.reshape(B, S, DA_HEADS, 2, DA_HEAD_DIM),
                            va.reshape(B, S, DA_HEADS, DA_V_DIM), lam)
        oa = (rmsnorm(oa, da_norm[i]) * (1.0 - lambda_init)).reshape(B, S, DA_V)
        ob = neighbourhood_attention(qn.reshape(B, S, NA_HEADS, NA_HEAD_DIM),
                                     kn.reshape(B, S, NA_HEADS, NA_HEAD_DIM),
                                     vn.reshape(B, S, NA_HEADS, NA_HEAD_DIM),
                                     na_rpb[i]).reshape(B, S, NA_W)
        qc = apply_rope(rmsnorm(qc.reshape(B, S, GQ_HEADS, GQ_HEAD_DIM), gq_q_norm[i]), cos, sin)
        kc = apply_rope(rmsnorm(kc.reshape(B, S, GQ_KV_HEADS, GQ_HEAD_DIM), gq_k_norm[i]), cos, sin)
        oc = gqa_attention(qc, kc, vc.reshape(B, S, GQ_KV_HEADS, GQ_HEAD_DIM))
        gates = jax.nn.sigmoid(gz.reshape(B, S, N_BRANCH, D_MODEL))
        merged = (gates[:, :, 0] * (oa @ w_br_a[i]) + gates[:, :, 1] * (ob @ w_br_b[i])
                  + gates[:, :, 2] * (oc @ w_br_c[i]))
        h = h + rmsnorm(merged @ w_o[i], g_post_mix[i])
        u = rmsnorm(h, g_pre_mlp[i])
        f = jnp.square(jax.nn.relu(u @ w_up[i])) @ w_down[i]
        h = h + rmsnorm(f, g_post_mlp[i])
        e = ple[i] @ w_ple[i]
        gate = jax.nn.sigmoid(h @ w_ple_gate[i])
        h = h + rmsnorm(e * gate, g_ple[i])
    return h


def setup_inputs(seed: int = 0) -> dict:
    key = jax.random.key(seed)
    ks = jax.random.split(key, 24)
    f32 = jnp.float32

    def nrm(k, shape, scale):
        return jax.random.normal(k, shape, f32) * scale

    def gain(k, shape):
        return 1.0 + 0.05 * jax.random.normal(k, shape, f32)

    return {
        "x_prompt": nrm(ks[0], (BATCH, SEQ, D_MODEL), 1.0),
        "x_sample": nrm(ks[1], (DEC_BATCH, DEC_SEQ, D_MODEL), 1.0),
        "p_prompt": nrm(ks[2], (DEPTH, BATCH, SEQ, PLE_DIM), 1.0),
        "p_sample": nrm(ks[3], (DEPTH, DEC_BATCH, DEC_SEQ, PLE_DIM), 1.0),
        "w_in": nrm(ks[4], (DEPTH, D_MODEL, IN_W), D_MODEL ** -0.5),
        "da_lambda": nrm(ks[5], (DEPTH, 4, DA_HEAD_DIM), 0.1),
        "da_norm": gain(ks[6], (DEPTH, DA_V_DIM)),
        "na_rpb": nrm(ks[7], (DEPTH, NA_HEADS, 2 * NA_ROWS_MAX - 1, 2 * NA_COLS - 1), 0.1),
        "gq_q_norm": gain(ks[8], (DEPTH, GQ_HEAD_DIM)),
        "gq_k_norm": gain(ks[9], (DEPTH, GQ_HEAD_DIM)),
        "w_br_a": nrm(ks[10], (DEPTH, DA_V, D_MODEL), DA_V ** -0.5),
        "w_br_b": nrm(ks[11], (DEPTH, NA_W, D_MODEL), NA_W ** -0.5),
        "w_br_c": nrm(ks[12], (DEPTH, GQ_Q, D_MODEL), GQ_Q ** -0.5),
        "w_o": nrm(ks[13], (DEPTH, D_MODEL, D_MODEL), D_MODEL ** -0.5),
        "g_pre_mix": gain(ks[14], (DEPTH, D_MODEL)),
        "g_post_mix": gain(ks[15], (DEPTH, D_MODEL)),
        "g_pre_mlp": gain(ks[16], (DEPTH, D_MODEL)),
        "g_post_mlp": gain(ks[17], (DEPTH, D_MODEL)),
        "w_up": nrm(ks[18], (DEPTH, D_MODEL, D_FF), D_MODEL ** -0.5),
        "w_down": nrm(ks[19], (DEPTH, D_FF, D_MODEL), D_FF ** -0.5),
        "w_ple": nrm(ks[20], (DEPTH, PLE_DIM, D_MODEL), PLE_DIM ** -0.5),
        "w_ple_gate": nrm(ks[21], (DEPTH, D_MODEL, D_MODEL), D_MODEL ** -0.5),
        "g_ple": gain(ks[22], (DEPTH, D_MODEL)),
    }


def reference(x_prompt, x_sample, p_prompt, p_sample, w_in, da_lambda, da_norm, na_rpb,
              gq_q_norm, gq_k_norm, w_br_a, w_br_b, w_br_c, w_o, g_pre_mix, g_post_mix,
              g_pre_mlp, g_post_mlp, w_up, w_down, w_ple, w_ple_gate, g_ple):
    y_prompt = run_trunk(x_prompt, p_prompt, w_in, da_lambda, da_norm, na_rpb, gq_q_norm, gq_k_norm,
                         w_br_a, w_br_b, w_br_c, w_o, g_pre_mix, g_post_mix, g_pre_mlp, g_post_mlp,
                         w_up, w_down, w_ple, w_ple_gate, g_ple)
    y_sample = run_trunk(x_sample, p_sample, w_in, da_lambda, da_norm, na_rpb, gq_q_norm, gq_k_norm,
                         w_br_a, w_br_b, w_br_c, w_o, g_pre_mix, g_post_mix, g_pre_mlp, g_post_mlp,
                         w_up, w_down, w_ple, w_ple_gate, g_ple)
    return (y_prompt, y_sample)
```

```cpp
#include <hip/hip_runtime.h>
#include <hip/hip_cooperative_groups.h>
#include <cstdio>
#include <cstdint>
namespace cg = cooperative_groups;
#define REP_DA 1
#define REP_GQA 1
#define REP_SYNC 1
#define REP_NA 1

#define LAS __attribute__((address_space(3)))
#define DI __device__ __forceinline__
typedef unsigned short bf16_t;
typedef short bf16x8 __attribute__((ext_vector_type(8)));
typedef short s16x4 __attribute__((ext_vector_type(4)));
typedef float f32x4 __attribute__((ext_vector_type(4)));
typedef float f32x16 __attribute__((ext_vector_type(16)));
typedef unsigned u32x4 __attribute__((ext_vector_type(4)));
typedef unsigned u32x2 __attribute__((ext_vector_type(2)));
typedef float f32x2_t __attribute__((ext_vector_type(2)));
typedef __bf16 bf16x2_t __attribute__((ext_vector_type(2)));

constexpr int DM = 1024, DEPTH = 4, TG = 16384, DFF = 4096, PLED = 256, INW = 10752;
constexpr int ZW = 8448, VW = 2304;
constexpr int Z_QA = 0, Z_KA = 1024, Z_QN = 2048, Z_KN = 3072, Z_QC = 4096, Z_KC = 5120, Z_GZ = 5376;
constexpr int V_A = 0, V_N = 1024, V_C = 2048;
constexpr float EPS = 1e-6f, LOG2E = 1.4426950408889634f;
constexpr size_t WL_IN = 0, WL_BR = WL_IN + (size_t)INW * DM, WL_O3 = WL_BR + (size_t)3072 * DM, WL_UP = WL_O3 + (size_t)DM * 3072,
                 WL_DN = WL_UP + (size_t)DFF * DM, WL_PL = WL_DN + (size_t)DM * DFF, WL_PG = WL_PL + (size_t)DM * PLED, WL_TOTAL = WL_PG + (size_t)DM * DM;
constexpr size_t MiB = 1u << 20;
constexpr size_t WS_W = 0, WS_Z = 208 * MiB, WS_VT = 472 * MiB, WS_U = 544 * MiB, WS_CTL = 576 * MiB, CTL_BYTES = 16384, WS_H16 = 578 * MiB, WS_END = 610 * MiB;
static_assert(WL_TOTAL * 2 * DEPTH <= WS_Z, "weights fit");
static_assert((size_t)TG * ZW * 2 == 264 * MiB && (size_t)VW * TG * 2 == 72 * MiB, "sizes");
constexpr size_t WS_F = WS_VT, WS_E = WS_VT + 32 * MiB, WS_UP = WS_Z, WS_HB = WS_Z + 128 * MiB, WS_PLEB = WS_Z + 160 * MiB;
constexpr int LDS_BYTES = 135168;

DI unsigned cvtpk(float lo, float hi) { f32x2_t v = {lo, hi}; bf16x2_t b = __builtin_convertvector(v, bf16x2_t); return __builtin_bit_cast(unsigned, b); }
DI float bf2f(unsigned short u) { return __builtin_bit_cast(float, (unsigned)u << 16); }
DI float bflo(unsigned u) { return __builtin_bit_cast(float, u << 16); }
DI float bfhi(unsigned u) { return __builtin_bit_cast(float, u & 0xffff0000u); }
DI void swap32(unsigned& a, unsigned& b) { asm volatile("s_nop 1\n\tv_permlane32_swap_b32 %0, %1\n\ts_nop 1" : "+v"(a), "+v"(b)); }
DI float xor32_max(float v) { unsigned a = __builtin_bit_cast(unsigned, v), b = a; swap32(a, b); return fmaxf(__builtin_bit_cast(float, a), __builtin_bit_cast(float, b)); }
DI float xor32_sum(float v) { unsigned a = __builtin_bit_cast(unsigned, v), b = a; swap32(a, b); return __builtin_bit_cast(float, a) + __builtin_bit_cast(float, b); }
template <int CTRL> DI float dpp_sum_step(float v) {
    return v + __builtin_bit_cast(float, __builtin_amdgcn_update_dpp(0, __builtin_bit_cast(int, v), CTRL, 0xF, 0xF, true));
}
DI float wave_sum(float v, int lane) {
    v = dpp_sum_step<0xB1>(v);
    v = dpp_sum_step<0x4E>(v);
    v = dpp_sum_step<0x141>(v);
    v = dpp_sum_step<0x140>(v);
    v += __builtin_bit_cast(float, __builtin_amdgcn_ds_bpermute((lane ^ 16) << 2, __builtin_bit_cast(int, v)));
    return xor32_sum(v);
}
DI float fexp2(float x) { return __builtin_amdgcn_exp2f(x); }
DI float sigmoidf_(float x) { return __builtin_amdgcn_rcpf(1.0f + fexp2(-x * LOG2E)); }

namespace pg8 {
constexpr int BM = 256, BK = 64, HALF = 128, HTB = HALF * BK * 2, STAGE_BYTES = 8 * HTB, NXCD = 8, WGM = 8;
__host__ __device__ __forceinline__ int lds_byte(int r, int c) { const int st = (r >> 4) * 2 + (c >> 5), rr = r & 15, cc = c & 31, ob = rr * 64 + cc * 2; return st * 1024 + (ob ^ (((ob >> 9) & 1) << 5)); }
__host__ __device__ __forceinline__ void stage_rc(int b, int& R, int& C) { const int st = b / 1024, sb = b % 1024, swz = sb ^ (((sb >> 9) & 1) << 5); R = (st >> 1) * 16 + swz / 64; C = (st & 1) * 32 + (swz % 64) / 2; }
__host__ __device__ __forceinline__ int perm32(int rho) { const int n = rho >> 4, i = rho & 15; return 8 * (i >> 2) + 4 * n + (i & 3); }

struct Unit { int pm, pn, sel; };
struct Gemm { const bf16_t* A; const bf16_t* Bt; int M, N, K, lda, ldb, a_shift; size_t a_stride; const bf16_t* A2; const bf16_t* Bt2; };

struct StaticOrder {
    int nM, nN, nwg, G, c;
    __host__ __device__ void init(int M, int N, int G_, int c_) { nM = M / BM; nN = N / BM; nwg = nM * nN; G = G_; c = c_; }
    __host__ __device__ bool next(int i, Unit& u) const { const int L = i * G + c; if (L >= nwg) return false; map(L, u); return true; }
    __host__ __device__ void map(int L, Unit& u) const {
        u.sel = 0;
        int wgid = L; { const int q = nwg / NXCD, r = nwg % NXCD, xcd = wgid % NXCD, off = wgid / NXCD; wgid = (xcd < r ? xcd * (q + 1) : r * (q + 1) + (xcd - r) * q) + off; }
        const int nig = WGM * nN, gid = wgid / nig, fm = gid * WGM, gsz = (nM - fm) < WGM ? (nM - fm) : WGM;
        u.pm = fm + ((wgid % nig) % gsz); u.pn = (wgid % nig) / gsz;
    }
};
struct DualOrder {
    StaticOrder a, b; int G, c;
    __host__ __device__ void init(int M1, int N1, int M2, int N2, int G_, int c_) { a.init(M1, N1, G_, c_); b.init(M2, N2, G_, c_); G = G_; c = c_; }
    __host__ __device__ bool next(int i, Unit& u) const {
        const int L = i * G + c;
        if (L < a.nwg) { a.map(L, u); return true; }
        if (L < a.nwg + b.nwg) { b.map(L - a.nwg, u); u.sel = 1; return true; }
        return false;
    }
};

template <int MODE> struct Epi {
    bf16_t* O; int ldc; const bf16_t* X; int ldx;
    DI void operator()(const f32x4 (&acc)[2][2][4][2], const Unit& u, int wr, int wc, int fr, int fq) const {
        const int row0 = u.pm * BM + wr * 64 + fr, col0 = u.pn * BM + wc * 32 + 8 * fq;
        if (MODE == 4) { if ((u.pn >> 2) != 0) __builtin_amdgcn_fence(__ATOMIC_ACQUIRE, "agent"); }
#pragma unroll
        for (int ai = 0; ai < 2; ++ai)
#pragma unroll
            for (int m = 0; m < 4; ++m) {
                const size_t r = (size_t)(row0 + ai * HALF + m * 16);
#pragma unroll
                for (int bj = 0; bj < 2; ++bj) {
                    const int c = col0 + bj * HALF;
                    f32x4 v0 = acc[ai][bj][m][0], v1 = acc[ai][bj][m][1];
                    if (MODE == 1 || MODE == 3) {
                        const u32x4 xv = *(const u32x4*)(X + r * ldx + c);
                        const float x0 = bflo(xv.x), x1 = bfhi(xv.x), x2 = bflo(xv.y), x3 = bfhi(xv.y), x4 = bflo(xv.z), x5 = bfhi(xv.z), x6 = bflo(xv.w), x7 = bfhi(xv.w);
                        if (MODE == 1) {
                            v0 = (f32x4){v0[0] * sigmoidf_(x0), v0[1] * sigmoidf_(x1), v0[2] * sigmoidf_(x2), v0[3] * sigmoidf_(x3)};
                            v1 = (f32x4){v1[0] * sigmoidf_(x4), v1[1] * sigmoidf_(x5), v1[2] * sigmoidf_(x6), v1[3] * sigmoidf_(x7)};
                        } else {
                            v0 = (f32x4){x0 * sigmoidf_(v0[0]), x1 * sigmoidf_(v0[1]), x2 * sigmoidf_(v0[2]), x3 * sigmoidf_(v0[3])};
                            v1 = (f32x4){x4 * sigmoidf_(v1[0]), x5 * sigmoidf_(v1[1]), x6 * sigmoidf_(v1[2]), x7 * sigmoidf_(v1[3])};
                        }
                    }
                    if (MODE == 4) {
                        const int jgrp = u.pn >> 2;
                        const u32x4 xv = *(const u32x4*)(X + r * ldx + c);
                        v0 = (f32x4){v0[0] * sigmoidf_(bflo(xv.x)), v0[1] * sigmoidf_(bfhi(xv.x)), v0[2] * sigmoidf_(bflo(xv.y)), v0[3] * sigmoidf_(bfhi(xv.y))};
                        v1 = (f32x4){v1[0] * sigmoidf_(bflo(xv.z)), v1[1] * sigmoidf_(bfhi(xv.z)), v1[2] * sigmoidf_(bflo(xv.w)), v1[3] * sigmoidf_(bfhi(xv.w))};
                        bf16_t* op = O + r * ldc + (c - 1024 * jgrp);
                        if (jgrp) { const u32x4 pv = *(const u32x4*)op;
                            v0 = v0 + (f32x4){bflo(pv.x), bfhi(pv.x), bflo(pv.y), bfhi(pv.y)}; v1 = v1 + (f32x4){bflo(pv.z), bfhi(pv.z), bflo(pv.w), bfhi(pv.w)}; }
                        u32x4 w; w.x = cvtpk(v0[0], v0[1]); w.y = cvtpk(v0[2], v0[3]); w.z = cvtpk(v1[0], v1[1]); w.w = cvtpk(v1[2], v1[3]);
                        *(u32x4*)op = w;
                        continue;
                    }
                    if (MODE == 2) {
#pragma unroll
                        for (int e = 0; e < 4; ++e) { const float a = fmaxf(v0[e], 0.f), b = fmaxf(v1[e], 0.f); v0[e] = a * a; v1[e] = b * b; }
                    }
                    u32x4 w; w.x = cvtpk(v0[0], v0[1]); w.y = cvtpk(v0[2], v0[3]); w.z = cvtpk(v1[0], v1[1]); w.w = cvtpk(v1[2], v1[3]);
                    if (MODE == 5 && u.sel) *(u32x4*)((bf16_t*)X + r * ldx + c) = w;
                    else *(u32x4*)(O + r * ldc + c) = w;
                }
            }
    }
};

struct BranchOrder {
    StaticOrder base;
    __host__ __device__ void init(int M, int G_, int c_) { base.init(M, 1024, G_, c_); }
    __host__ __device__ bool next(int i, Unit& u) const {
        const int ti = i / 3, j = i - 3 * ti; Unit t;
        if (!base.next(ti, t)) return false;
        u.pm = t.pm; u.pn = j * 4 + t.pn; u.sel = 0; return true;
    }
};
template <class EpiT, bool ALIGN_EPI, class Sched>
DI void gemm_phase(LAS unsigned char* lds, const Gemm g, const Sched& S, const EpiT& E) {
    int tid_ = threadIdx.x; asm volatile("" : "+v"(tid_));
    const int tid = tid_, wid = __builtin_amdgcn_readfirstlane(tid >> 6), lane = tid & 63, wr = wid >> 2, wc = wid & 3, fr = lane & 15, fq = lane >> 4;
    const int K = g.K, nt = K / BK;
    unsigned voffA[2], voffB[2];
#pragma unroll
    for (int i = 0; i < 2; ++i) { int R, C; stage_rc(tid * 16 + i * 8192, R, C); const int Rb = (R & ~31) + perm32(R & 31);
        voffA[i] = (unsigned)(R * g.lda + C) * 2u; voffB[i] = (unsigned)(Rb * g.ldb + C) * 2u; }
    const size_t kstep = (size_t)(BK * 2);
    const size_t hstepA = (size_t)HALF * g.lda * 2, hstepB = (size_t)HALF * g.ldb * 2;
    const size_t tstepA = 2 * hstepA, tstepB = 2 * hstepB;
    const unsigned ldsw = (unsigned)wid * 1024u;
    const int aoff = lds_byte(wr * 64 + fr, fq * 8), boff = lds_byte(wc * 32 + fr, fq * 8);
#define PG8_SA(b, h) (((b) * 2 + (h)) * HTB)
#define PG8_SB(b, h) ((4 + (b) * 2 + (h)) * HTB)
#define PG8_STAGE(bufoff, gbase, voff) do { _Pragma("unroll") for (int _i = 0; _i < 2; ++_i) \
        __builtin_amdgcn_global_load_lds((const unsigned*)((const char*)(gbase) + (voff)[_i]), (LAS unsigned*)(lds + (bufoff) + ldsw + _i * 8192), 16, 0, 0); } while (0)
#define PG8_LDA(dst, b, h) do { _Pragma("unroll") for (int m = 0; m < 4; ++m) _Pragma("unroll") for (int k = 0; k < 2; ++k) dst[m][k] = *(const LAS bf16x8*)(lds + PG8_SA(b, h) + aoff + m * 2048 + k * 1024); } while (0)
#define PG8_LDB(dst, b, h) do { _Pragma("unroll") for (int n = 0; n < 2; ++n) _Pragma("unroll") for (int k = 0; k < 2; ++k) dst[n][k] = *(const LAS bf16x8*)(lds + PG8_SB(b, h) + boff + n * 2048 + k * 1024); } while (0)
#define PG8_MMA(ai, bj, At, Bt) do { __builtin_amdgcn_s_setprio(1); _Pragma("unroll") for (int m = 0; m < 4; ++m) _Pragma("unroll") for (int n = 0; n < 2; ++n) _Pragma("unroll") for (int k = 0; k < 2; ++k) \
        acc[ai][bj][m][n] = __builtin_amdgcn_mfma_f32_16x16x32_bf16(Bt[n][k], At[m][k], acc[ai][bj][m][n], 0, 0, 0); __builtin_amdgcn_s_setprio(0); } while (0)
#define PG8_WAIT_V(n) asm volatile("s_waitcnt vmcnt(" #n ")" ::: "memory")
#define PG8_WAIT_L(n) asm volatile("s_waitcnt lgkmcnt(" #n ")" ::: "memory")
#define PG8_BAR __builtin_amdgcn_s_barrier()
#define PG8_SCHED __builtin_amdgcn_sched_barrier(0)
#define PG8_AOF(u) ((const char*)((u).sel ? g.A2 : g.A) + (size_t)(u).pm * tstepA + (size_t)((u).pn >> g.a_shift) * g.a_stride)
#define PG8_BOF(u) ((const char*)((u).sel ? g.Bt2 : g.Bt) + (size_t)(u).pn * tstepB)
    Unit cur, nxt; int ui = 0;
    if (!S.next(0, cur)) return;
    f32x4 acc[2][2][4][2];
#pragma unroll
    for (int a = 0; a < 2; ++a)
#pragma unroll
        for (int b = 0; b < 2; ++b)
#pragma unroll
            for (int m = 0; m < 4; ++m)
#pragma unroll
                for (int n = 0; n < 2; ++n) acc[a][b][m][n] = (f32x4){0.f, 0.f, 0.f, 0.f};
    bf16x8 At[4][2], B0[2][2], B1[2][2];
    const char* cA = PG8_AOF(cur); const char* cB = PG8_BOF(cur);
    PG8_STAGE(PG8_SB(0, 0), cB, voffB); PG8_STAGE(PG8_SB(0, 1), cB + hstepB, voffB); PG8_STAGE(PG8_SA(0, 0), cA, voffA); PG8_STAGE(PG8_SA(0, 1), cA + hstepA, voffA);
    if (wr == 1) PG8_BAR;
    PG8_WAIT_V(2); PG8_BAR;
    PG8_STAGE(PG8_SB(1, 0), cB + kstep, voffB); PG8_STAGE(PG8_SA(1, 0), cA + kstep, voffA); PG8_STAGE(PG8_SB(1, 1), cB + hstepB + kstep, voffB);
    PG8_WAIT_V(6); PG8_BAR;
    for (;;) {
        const bool has_next = S.next(ui + 1, nxt);
        const char* nA = has_next ? PG8_AOF(nxt) : cA; const char* nB = has_next ? PG8_BOF(nxt) : cB;
        for (int t = 0; t < nt; t += 2) {
            const bool last = (t == nt - 2);
            const char* a1 = cA + (size_t)(t + 1) * kstep;
            const char* a2 = last ? nA : cA + (size_t)(t + 2) * kstep; const char* b2 = last ? nB : cB + (size_t)(t + 2) * kstep;
            const char* a3 = a2 + kstep; const char* b3 = b2 + kstep;
            PG8_LDB(B0, 0, 0); PG8_LDB(B1, 0, 1); PG8_SCHED; PG8_LDA(At, 0, 0); PG8_STAGE(PG8_SA(1, 1), a1 + hstepA, voffA);
            PG8_WAIT_V(8); PG8_WAIT_L(0); PG8_BAR; PG8_MMA(0, 0, At, B0); PG8_MMA(0, 1, At, B1); PG8_BAR; PG8_SCHED;
            PG8_LDA(At, 0, 1); PG8_STAGE(PG8_SB(0, 0), b2, voffB); PG8_STAGE(PG8_SB(0, 1), b2 + hstepB, voffB); PG8_STAGE(PG8_SA(0, 0), a2, voffA);
            PG8_WAIT_V(8); PG8_WAIT_L(0); PG8_BAR; PG8_MMA(1, 0, At, B0); PG8_MMA(1, 1, At, B1); PG8_BAR; PG8_SCHED;
            PG8_LDB(B0, 1, 0); PG8_LDB(B1, 1, 1); PG8_SCHED; PG8_LDA(At, 1, 0); PG8_STAGE(PG8_SA(0, 1), a2 + hstepA, voffA);
            PG8_WAIT_V(8); PG8_WAIT_L(0); PG8_BAR; PG8_MMA(0, 0, At, B0); PG8_MMA(0, 1, At, B1); PG8_BAR; PG8_SCHED;
            PG8_LDA(At, 1, 1); PG8_STAGE(PG8_SB(1, 0), b3, voffB); PG8_STAGE(PG8_SB(1, 1), b3 + hstepB, voffB); PG8_STAGE(PG8_SA(1, 0), a3, voffA);
            PG8_WAIT_V(8); PG8_WAIT_L(0); PG8_BAR; PG8_MMA(1, 0, At, B0); PG8_MMA(1, 1, At, B1); PG8_BAR; PG8_SCHED;
        }
        if constexpr (ALIGN_EPI) { if (wr == 0) PG8_BAR; }
        E(acc, cur, wr, wc, fr, fq);
        if (!has_next) break;
#pragma unroll
        for (int a = 0; a < 2; ++a)
#pragma unroll
            for (int b = 0; b < 2; ++b)
#pragma unroll
                for (int m = 0; m < 4; ++m)
#pragma unroll
                    for (int n = 0; n < 2; ++n) acc[a][b][m][n] = (f32x4){0.f, 0.f, 0.f, 0.f};
        cur = nxt; cA = nA; cB = nB; ++ui;
        if constexpr (ALIGN_EPI) { if (wr == 1) PG8_BAR; }
    }
    PG8_WAIT_V(0);
    if constexpr (!ALIGN_EPI) { if (wr == 0) PG8_BAR; }
    PG8_BAR;
#undef PG8_SA
#undef PG8_SB
#undef PG8_STAGE
#undef PG8_LDA
#undef PG8_LDB
#undef PG8_MMA
#undef PG8_WAIT_V
#undef PG8_WAIT_L
#undef PG8_BAR
#undef PG8_SCHED
#undef PG8_AOF
#undef PG8_BOF
}
}

template <int MODE>
DI void run_gemm(LAS unsigned char* lds, const bf16_t* A, int lda, const bf16_t* Bt, int ldb, int M, int N, int K, bf16_t* O, int ldc, const bf16_t* X, int ldx,
                 int a_shift = 0, size_t a_stride = 0) {
    pg8::Gemm g{A, Bt, M, N, K, lda, ldb, a_shift, a_stride, A, Bt};
    int G_ = (int)gridDim.x, c_ = (int)blockIdx.x; asm volatile("" : "+s"(G_), "+s"(c_));
    pg8::StaticOrder S; S.init(M, N, G_, c_);
    pg8::Epi<MODE> E{O, ldc, X, ldx};
    pg8::gemm_phase<pg8::Epi<MODE>, true, pg8::StaticOrder>(lds, g, S, E);
    __syncthreads();
}
DI void run_gemm_inproj(LAS unsigned char* lds, const bf16_t* U, const bf16_t* Win, bf16_t* Z, bf16_t* VT) {
    pg8::Gemm g{U, Win, TG, ZW, DM, DM, DM, 0, 0, Win + (size_t)ZW * DM, U};
    int G_ = (int)gridDim.x, c_ = (int)blockIdx.x; asm volatile("" : "+s"(G_), "+s"(c_));
    pg8::DualOrder S; S.init(TG, ZW, VW, TG, G_, c_);
    pg8::Epi<5> E{Z, ZW, VT, TG};
    pg8::gemm_phase<pg8::Epi<5>, true, pg8::DualOrder>(lds, g, S, E);
    __syncthreads();
}
DI void run_gemm_branch(LAS unsigned char* lds, bf16_t* Z, const bf16_t* Wbr) {
    pg8::Gemm g{Z, Wbr, TG, 3072, DM, ZW, DM, 2, (size_t)2048 * 2, Z, Wbr};
    int G_ = (int)gridDim.x, c_ = (int)blockIdx.x; asm volatile("" : "+s"(G_), "+s"(c_));
    pg8::BranchOrder S; S.init(TG, G_, c_);
    pg8::Epi<4> E{Z + Z_GZ, ZW, Z + Z_GZ, ZW};
    pg8::gemm_phase<pg8::Epi<4>, true, pg8::BranchOrder>(lds, g, S, E);
    __syncthreads();
}

DI void transpose_item(const float* W, int ldw, int col0, int K, bf16_t* WT, int ldt, int drow0, int dcol0, LAS float* scr, int kb, int nb, int lane, float sc) {
    const int k0 = 64 * kb, n0 = 64 * nb, c = lane & 15, kr = lane >> 4;
    f32x4 v[16];
    const float* src = W + (size_t)(k0 + kr) * ldw + col0 + n0 + 4 * c;
#pragma unroll
    for (int i = 0; i < 16; ++i) v[i] = *(const f32x4*)(src + (size_t)(4 * i) * ldw);
#pragma unroll
    for (int i = 0; i < 16; ++i) { LAS float* d = scr + (4 * c) * 65 + 4 * i + kr; d[0] = v[i].x; d[65] = v[i].y; d[130] = v[i].z; d[195] = v[i].w; }
    asm volatile("s_waitcnt lgkmcnt(0)" ::: "memory");
    const int ch = lane & 7;
#pragma unroll
    for (int j = 0; j < 8; ++j) { const int n = (lane >> 3) + 8 * j; const LAS float* s = scr + n * 65 + 8 * ch;
        u32x4 o; o.x = cvtpk(s[0] * sc, s[1] * sc); o.y = cvtpk(s[2] * sc, s[3] * sc); o.z = cvtpk(s[4] * sc, s[5] * sc); o.w = cvtpk(s[6] * sc, s[7] * sc);
        *(u32x4*)(WT + (size_t)(drow0 + n0 + n) * ldt + dcol0 + k0 + 8 * ch) = o; }
    asm volatile("s_waitcnt lgkmcnt(0)" ::: "memory");
}

constexpr float QSC64 = 0.125f * LOG2E;
struct Seg { int in, ldw, col0, ncols, K, ldt, drow0, dcol0; size_t woff; float scale; };
DI Seg get_seg(int s) {
    switch (s) {
    case 0:  return Seg{4, INW, 0, 1024, DM, DM, 0, 0, WL_IN, QSC64};
    case 1:  return Seg{4, INW, 1024, 1024, DM, DM, 1024, 0, WL_IN, 1.f};
    case 2:  return Seg{4, INW, 3072, 1024, DM, DM, 2048, 0, WL_IN, QSC64};
    case 3:  return Seg{4, INW, 4096, 1024, DM, DM, 3072, 0, WL_IN, 1.f};
    case 4:  return Seg{4, INW, 6144, 1280, DM, DM, 4096, 0, WL_IN, 1.f};
    case 5:  return Seg{4, INW, 7680, 3072, DM, DM, 5376, 0, WL_IN, 1.f};
    case 6:  return Seg{4, INW, 2048, 1024, DM, DM, 8448, 0, WL_IN, 1.f};
    case 7:  return Seg{4, INW, 5120, 1024, DM, DM, 9472, 0, WL_IN, 1.f};
    case 8:  return Seg{4, INW, 7424, 256, DM, DM, 10496, 0, WL_IN, 1.f};
    case 9:  return Seg{10, DM, 0, DM, DM, DM, 0, 0, WL_BR, 1.f};
    case 10: return Seg{11, DM, 0, DM, DM, DM, 1024, 0, WL_BR, 1.f};
    case 11: return Seg{12, DM, 0, DM, DM, DM, 2048, 0, WL_BR, 1.f};
    case 12: return Seg{13, DM, 0, DM, DM, DM, 0, 0, WL_O3, 1.f};
    case 13: return Seg{18, DFF, 0, DFF, DM, DM, 0, 0, WL_UP, 1.f};
    case 14: return Seg{19, DM, 0, DM, DFF, DFF, 0, 0, WL_DN, 1.f};
    case 15: return Seg{20, DM, 0, DM, PLED, PLED, 0, 0, WL_PL, 1.f};
    default: return Seg{21, DM, 0, DM, DM, DM, 0, 0, WL_PG, 1.f};
    }
}
constexpr int NSEG = 17;

template <bool HIN_F32, bool HOUT_F32>
DI void row_phase(const void* hin_, const bf16_t* F, const float* gpost, void* hout_, const float* gnext, bf16_t* U, int gw, int NGW) {
    int tid_ = threadIdx.x; asm volatile("" : "+v"(tid_)); const int lane = tid_ & 63;
    constexpr int RB = 4;
    for (int m0 = gw; m0 < TG; m0 += RB * NGW) {
        f32x4 v[RB][4]; u32x2 fw[RB][4];
#pragma unroll
        for (int k = 0; k < RB; ++k) {
            const int m = m0 + k * NGW; const bool ok = m < TG; const size_t mm = ok ? m : m0;
            if (HIN_F32) { const f32x4* xr = (const f32x4*)((const float*)hin_ + mm * DM) + lane;
#pragma unroll
                for (int j = 0; j < 4; ++j) v[k][j] = xr[64 * j]; }
            else { const u32x2* xr = (const u32x2*)((const bf16_t*)hin_ + mm * DM) + lane;
#pragma unroll
                for (int j = 0; j < 4; ++j) { const u32x2 w = xr[64 * j]; v[k][j] = (f32x4){bflo(w.x), bfhi(w.x), bflo(w.y), bfhi(w.y)}; } }
            if (F) { const u32x2* fr_ = (const u32x2*)(F + mm * DM) + lane;
#pragma unroll
                for (int j = 0; j < 4; ++j) fw[k][j] = fr_[64 * j]; }
        }
        f32x4 gp[4], gn[4];
        if (F) {
#pragma unroll
            for (int j = 0; j < 4; ++j) gp[j] = *((const f32x4*)gpost + lane + 64 * j);
        }
        if (U) {
#pragma unroll
            for (int j = 0; j < 4; ++j) gn[j] = *((const f32x4*)gnext + lane + 64 * j);
        }
#pragma unroll
        for (int k = 0; k < RB; ++k) {
            const int m = m0 + k * NGW; if (m >= TG) continue;
            if (F) {
                f32x4 f[4]; float ss = 0.f;
#pragma unroll
                for (int j = 0; j < 4; ++j) { const u32x2 w = fw[k][j]; f[j] = (f32x4){bflo(w.x), bfhi(w.x), bflo(w.y), bfhi(w.y)}; ss += (f[j].x * f[j].x + f[j].y * f[j].y) + (f[j].z * f[j].z + f[j].w * f[j].w); }
                const float rs = __builtin_amdgcn_rsqf(wave_sum(ss, lane) * (1.f / DM) + EPS);
#pragma unroll
                for (int j = 0; j < 4; ++j) v[k][j] = v[k][j] + f[j] * rs * gp[j];
            }
            if (HOUT_F32) { f32x4* orow = (f32x4*)((float*)hout_ + (size_t)m * DM) + lane;
#pragma unroll
                for (int j = 0; j < 4; ++j) orow[64 * j] = v[k][j]; }
            else { u32x2* o8 = (u32x2*)((bf16_t*)hout_ + (size_t)m * DM) + lane;
#pragma unroll
                for (int j = 0; j < 4; ++j) o8[64 * j] = (u32x2){cvtpk(v[k][j].x, v[k][j].y), cvtpk(v[k][j].z, v[k][j].w)}; }
            if (U) {
                float ss = 0.f;
#pragma unroll
                for (int j = 0; j < 4; ++j) ss += (v[k][j].x * v[k][j].x + v[k][j].y * v[k][j].y) + (v[k][j].z * v[k][j].z + v[k][j].w * v[k][j].w);
                const float rs = __builtin_amdgcn_rsqf(wave_sum(ss, lane) * (1.f / DM) + EPS);
                u32x2* o8 = (u32x2*)(U + (size_t)m * DM) + lane;
#pragma unroll
                for (int j = 0; j < 4; ++j) { const f32x4 y = v[k][j] * rs * gn[j]; o8[64 * j] = (u32x2){cvtpk(y.x, y.y), cvtpk(y.z, y.w)}; }
            }
        }
    }
}
DI void ple_phase(const float* ple, bf16_t* PB, int gw, int NGW) {
    int tid_ = threadIdx.x; asm volatile("" : "+v"(tid_)); const int lane = tid_ & 63;
    for (int m0 = gw; m0 < TG; m0 += 8 * NGW) {
        f32x4 v[8];
#pragma unroll
        for (int k = 0; k < 8; ++k) { const int m = m0 + k * NGW; const size_t mm = m < TG ? m : m0; v[k] = *((const f32x4*)(ple + mm * PLED) + lane); }
#pragma unroll
        for (int k = 0; k < 8; ++k) { const int m = m0 + k * NGW; if (m < TG) *((u32x2*)(PB + (size_t)m * PLED) + lane) = (u32x2){cvtpk(v[k].x, v[k].y), cvtpk(v[k].z, v[k].w)}; }
    }
}
DI void rope_phase(bf16_t* Z, const float* gq, const float* gk, int S, int gw, int NGW, unsigned* kmax_word, unsigned* kcmax_word) {
    int tid_ = threadIdx.x; asm volatile("" : "+v"(tid_)); const int lane = tid_ & 63;
    const float freq = fexp2(-(float)(lane & 31) * 0.41524101186092029f);
    constexpr float QSC128 = 0.08838834764831845f * LOG2E;
    const float gq0 = gq[2 * lane] * QSC128, gq1 = gq[2 * lane + 1] * QSC128, gk0 = gk[2 * lane], gk1 = gk[2 * lane + 1];
    float kcmax2 = 0.f;
    float kmax2 = 0.f;
    for (int t0 = gw; t0 < TG; t0 += 2 * NGW) {
        unsigned w[2][10]; u32x4 ka[2][2];
#pragma unroll
        for (int k = 0; k < 2; ++k) { const int t = t0 + k * NGW; const size_t tt = t < TG ? t : t0;
            const u32x4* kp_ = (const u32x4*)(Z + tt * ZW + Z_KA) + 2 * lane; ka[k][0] = kp_[0]; ka[k][1] = kp_[1]; }
#pragma unroll
        for (int k = 0; k < 2; ++k) { const int t = t0 + k * NGW; const size_t tt = t < TG ? t : t0;
            const unsigned* base = (const unsigned*)(Z + tt * ZW + Z_QC) + lane;
#pragma unroll
            for (int hh = 0; hh < 10; ++hh) w[k][hh] = base[64 * hh]; }
#pragma unroll
        for (int k = 0; k < 2; ++k) {
            const int t = t0 + k * NGW; if (t >= TG) continue;
            { float ss = 0.f;
#pragma unroll
              for (int e = 0; e < 2; ++e) { const u32x4 x = ka[k][e]; const float a0 = bflo(x.x), a1 = bfhi(x.x), a2 = bflo(x.y), a3 = bfhi(x.y), a4 = bflo(x.z), a5 = bfhi(x.z), a6 = bflo(x.w), a7 = bfhi(x.w);
                  ss += (a0 * a0 + a1 * a1) + (a2 * a2 + a3 * a3) + (a4 * a4 + a5 * a5) + (a6 * a6 + a7 * a7); }
              ss += __builtin_bit_cast(float, __builtin_amdgcn_ds_bpermute((lane ^ 1) << 2, __builtin_bit_cast(int, ss)));
              ss += __builtin_bit_cast(float, __builtin_amdgcn_ds_bpermute((lane ^ 2) << 2, __builtin_bit_cast(int, ss)));
              kmax2 = fmaxf(kmax2, ss); }
            unsigned* base = (unsigned*)(Z + (size_t)t * ZW + Z_QC) + lane;
            const int s = t % S, prow = s >> 6, pcol = s & 63;
            const float ang = (float)(lane < 32 ? prow : pcol) * freq, rev = ang * 0.15915494309189535f;
            const float sn = __builtin_amdgcn_sinf(rev), cs = __builtin_amdgcn_cosf(rev);
#pragma unroll
            for (int hh = 0; hh < 10; ++hh) {
                const float x0 = bflo(w[k][hh]), x1 = bfhi(w[k][hh]);
                const float rs = __builtin_amdgcn_rsqf(wave_sum(x0 * x0 + x1 * x1, lane) * (1.f / 128.f) + EPS);
                const float y0 = x0 * rs * (hh < 8 ? gq0 : gk0), y1 = x1 * rs * (hh < 8 ? gq1 : gk1);
                if (hh >= 8) kcmax2 = fmaxf(kcmax2, wave_sum(y0 * y0 + y1 * y1, lane));
                base[64 * hh] = cvtpk(y0 * cs - y1 * sn, y0 * sn + y1 * cs);
            }
        }
    }
#pragma unroll
    for (int o = 4; o < 32; o <<= 1) kmax2 = fmaxf(kmax2, __builtin_bit_cast(float, __builtin_amdgcn_ds_bpermute((lane ^ o) << 2, __builtin_bit_cast(int, kmax2))));
    kmax2 = xor32_max(kmax2);
    if (lane == 0) (void)__hip_atomic_fetch_max(kmax_word, __builtin_bit_cast(unsigned, kmax2), __ATOMIC_RELAXED, __HIP_MEMORY_SCOPE_AGENT);
    if (lane == 0) (void)__hip_atomic_fetch_max(kcmax_word, __builtin_bit_cast(unsigned, kcmax2), __ATOMIC_RELAXED, __HIP_MEMORY_SCOPE_AGENT);
}

#define MFMA32(a, b, c) __builtin_amdgcn_mfma_f32_32x32x16_bf16((a), (b), (c), 0, 0, 0)
constexpr int AT_KS = 0, AT_VS = 33792, AT_RPB = 33792 + 36864;
constexpr int VSTR_B = 136;

template <int ROWS, int ROWLEN, int N>
DI void tile_gload(u32x4 (&v)[N], const bf16_t* src, unsigned ld, int tid) {
    static_assert(N * 512 * 8 == ROWS * ROWLEN, "tile");
    constexpr int CPR = ROWLEN / 8;
#pragma unroll
    for (int i = 0; i < N; ++i) { const unsigned c = (unsigned)tid + 512u * i, row = c / CPR, ch = c % CPR; const unsigned off = (row * ld + ch * 8u) * 2u; v[i] = *(const u32x4*)((const char*)src + off); }
}
template <int ROWS, int ROWLEN, int N>
DI void tile_sstore(const u32x4 (&v)[N], LAS unsigned char* dst, int tid) {
    constexpr int CPR = ROWLEN / 8, STR = (ROWLEN == 64) ? 136 : (ROWLEN + 8) * 2;
#pragma unroll
    for (int i = 0; i < N; ++i) { const int c = tid + 512 * i, row = c / CPR, ch = c % CPR;
        if (ROWLEN == 64) { *(LAS u32x2*)(dst + row * STR + ch * 16) = (u32x2){v[i].x, v[i].y}; *(LAS u32x2*)(dst + row * STR + ch * 16 + 8) = (u32x2){v[i].z, v[i].w}; }
        else *(LAS u32x4*)(dst + row * STR + ch * 16) = v[i]; }
}
template <int NDS>
DI f32x16 qk_block(const LAS unsigned char* kp, const bf16x8* qf, f32x16 s = (f32x16){}) {
#pragma unroll
    for (int ds = 0; ds < NDS; ++ds) { const bf16x8 a = *(const LAS bf16x8*)(kp + ds * 32); s = MFMA32(a, qf[ds], s); }
    return s;
}
DI bf16x8 pack8(const f32x16& p, int s2) {
    u32x4 w;
    if (s2 == 0) { w.x = cvtpk(p[0], p[1]); w.y = cvtpk(p[2], p[3]); w.z = cvtpk(p[4], p[5]); w.w = cvtpk(p[6], p[7]); }
    else { w.x = cvtpk(p[8], p[9]); w.y = cvtpk(p[10], p[11]); w.z = cvtpk(p[12], p[13]); w.w = cvtpk(p[14], p[15]); }
    return __builtin_bit_cast(bf16x8, w);
}
template <int NDB>
DI void pv_block(f32x16* o, const LAS unsigned char* vp, bf16x8 pf0, bf16x8 pf1) {
#pragma unroll
    for (int db = 0; db < NDB; ++db) {
        const LAS unsigned char* p = vp + db * 32 * VSTR_B;
        const s16x4 lo0 = *(const LAS s16x4*)(p), hi0 = *(const LAS s16x4*)(p + 16), lo1 = *(const LAS s16x4*)(p + 32), hi1 = *(const LAS s16x4*)(p + 48);
        const bf16x8 v0 = __builtin_shufflevector(lo0, hi0, 0, 1, 2, 3, 4, 5, 6, 7), v1 = __builtin_shufflevector(lo1, hi1, 0, 1, 2, 3, 4, 5, 6, 7);
        o[db] = MFMA32(v0, pf0, o[db]); o[db] = MFMA32(v1, pf1, o[db]);
    }
}
DI float max16(const f32x16& s) {
    float a = fmaxf(fmaxf(s[0], s[1]), fmaxf(s[2], s[3])), b = fmaxf(fmaxf(s[4], s[5]), fmaxf(s[6], s[7]));
    float c = fmaxf(fmaxf(s[8], s[9]), fmaxf(s[10], s[11])), d = fmaxf(fmaxf(s[12], s[13]), fmaxf(s[14], s[15]));
    return fmaxf(fmaxf(a, b), fmaxf(c, d));
}
template <int NDB, bool MASKED>
DI void softmax_pv(f32x16& s, float c, float& m, float& l, f32x16* o, const LAS unsigned char* vp) {
    float mx = max16(s) * c; mx = xor32_max(mx);
    const float mn = fmaxf(m, mx);
    const float ms = (MASKED && mn == -INFINITY) ? 0.f : mn;
    const float alpha = fexp2(m - ms);
    float ls = 0.f;
#pragma unroll
    for (int i = 0; i < 16; ++i) { s[i] = fexp2(__builtin_fmaf(s[i], c, -ms)); ls += s[i]; }
    l = l * alpha + ls; m = mn;
    if (__any(alpha != 1.0f)) {
#pragma unroll
        for (int db = 0; db < NDB; ++db)
#pragma unroll
            for (int i = 0; i < 16; ++i) { float x = o[db][i] * alpha; asm volatile("" : "+v"(x)); o[db][i] = x; }
    }
    pv_block<NDB>(o, vp, pack8(s, 0), pack8(s, 1));
}
DI void stats_step(const f32x16& s, float& m, float& l) {
    float mx = max16(s); mx = xor32_max(mx);
    const float mn = fmaxf(m, mx);
    float ls = 0.f;
#pragma unroll
    for (int i = 0; i < 16; ++i) ls += fexp2(s[i] - mn);
    l = l * fexp2(m - mn) + ls; m = mn;
}
template <int NDB, bool GAIN>
DI void store_o(const f32x16* o, bf16_t* dst  , float sc, const float* gain, int h) {
#pragma unroll
    for (int db = 0; db < NDB; ++db)
#pragma unroll
        for (int k = 0; k < 4; k += 2) {
            unsigned pa[2], pb[2];
#pragma unroll
            for (int gi = 0; gi < 2; ++gi) {
                const int g = k + gi, d = 32 * db + 8 * g + 4 * h;
                float a = o[db][4 * g] * sc, b = o[db][4 * g + 1] * sc, c = o[db][4 * g + 2] * sc, e = o[db][4 * g + 3] * sc;
                if (GAIN) { const f32x4 gg = *(const f32x4*)(gain + d); a *= gg.x; b *= gg.y; c *= gg.z; e *= gg.w; }
                if (gi == 0) { pa[0] = cvtpk(a, b); pa[1] = cvtpk(c, e); } else { pb[0] = cvtpk(a, b); pb[1] = cvtpk(c, e); }
            }
            swap32(pa[0], pb[0]); swap32(pa[1], pb[1]);
            *(u32x4*)(dst + 32 * db + 8 * (k + h)) = (u32x4){pa[0], pa[1], pb[0], pb[1]};
        }
}

constexpr int DA_KS = 0, DA_VS = 17408, DA_STG = 34816, DA_XO = 36864, DA_XS = 102400;
template <bool st> DI void da_unit(int layer, int b, int hd, int qb, int S, bf16_t* Z, const bf16_t* VT, const float* da_lambda, const float* da_norm, LAS unsigned char* lds, const unsigned* kmax_word) {
    int tid_ = threadIdx.x; asm volatile("" : "+v"(tid_));
    const int tid = tid_, lane = tid & 63, r = lane & 31, h = lane >> 5, wid = __builtin_amdgcn_readfirstlane(tid >> 6);
    const int mp = wid >> 2, wr = wid & 3;
    const int tb = b * S, q0 = qb * 128 + wr * 32, qpos = q0 + r, NT = S / 64;
    bf16_t* qrow = Z + (size_t)(tb + q0 + r) * ZW + Z_QA + hd * 128;
    const float sl = fexp2(-(float)(hd + 1)) * LOG2E;
    bf16x8 qf[4];
    float qn2 = 0.f;
#pragma unroll
    for (int ds = 0; ds < 4; ++ds) { qf[ds] = *(const bf16x8*)(qrow + mp * 64 + 16 * ds + 8 * h);
#pragma unroll
        for (int j = 0; j < 8; ++j) { const float x = bf2f((unsigned short)qf[ds][j]); qn2 += x * x; } }
    qn2 = xor32_sum(qn2);
    float qm = qn2;
#pragma unroll
    for (int o_ = 1; o_ < 32; o_ <<= 1) qm = fmaxf(qm, __builtin_bit_cast(float, __builtin_amdgcn_ds_bpermute((lane ^ o_) << 2, __builtin_bit_cast(int, qm))));
    LAS float* xs = (LAS float*)(lds + DA_XS);
    __syncthreads();
    if (lane == 0) xs[wid] = qm;
    __syncthreads();
    float qb2 = xs[0];
#pragma unroll
    for (int w = 1; w < 8; ++w) qb2 = fmaxf(qb2, xs[w]);
    const float kmax2 = __builtin_bit_cast(float, __hip_atomic_load(kmax_word, __ATOMIC_RELAXED, __HIP_MEMORY_SCOPE_AGENT));
    const float sbnd = __builtin_sqrtf(qb2 * kmax2) * 1.01f;
    const float D = (2.f * sbnd + 150.f) / sl, Q0 = (float)(qb * 128);
    const float lo = __builtin_ceilf((Q0 - 63.f - D) * (1.f / 64.f)), hi = __builtin_floorf((Q0 + 127.f + D) * (1.f / 64.f));
    int t_lo = lo < 0.f ? 0 : (int)lo, t_hi = hi > (float)(NT - 1) ? NT - 1 : (int)hi;
    t_lo = __builtin_amdgcn_readfirstlane(t_lo); t_hi = __builtin_amdgcn_readfirstlane(t_hi);
    const float sq = __builtin_sqrtf(qn2 * kmax2) * 1.01f;
    const float mref = fminf(sq, 100.f - sq);
    const bool fast = sbnd <= 110.f;
    const bf16_t* kt = Z + (size_t)tb * ZW + Z_KA + hd * 128;
    const bf16_t* vt = VT + (size_t)(V_A + hd * 128) * TG + tb;
    LAS unsigned char* KS = lds + DA_KS; LAS unsigned char* VS = lds + DA_VS;
    const LAS unsigned char* kp = KS + r * 272 + (mp * 64 + 8 * h) * 2;
    const LAS unsigned char* vp = VS + r * VSTR_B + 8 * h;
    const float slc = -sl;
    float l = 0.f;
    f32x16 o[4];
#pragma unroll
    for (int db = 0; db < 4; ++db) o[db] = (f32x16){};
    u32x4 kr[2], vr[2];
    tile_gload<64, 128>(kr, kt + (size_t)t_lo * 64 * ZW, ZW, tid); tile_gload<128, 64>(vr, vt + (size_t)t_lo * 64, TG, tid);
    if (fast) {
        const float mrc = -mref;
        tile_sstore<64, 128>(kr, KS, tid); tile_sstore<128, 64>(vr, VS, tid);
        if (t_lo + 1 <= t_hi) { tile_gload<64, 128>(kr, kt + (size_t)(t_lo + 1) * 64 * ZW, ZW, tid); tile_gload<128, 64>(vr, vt + (size_t)(t_lo + 1) * 64, TG, tid); }
        __syncthreads();
        for (int t = t_lo; t <= t_hi; ++t) {
            const int cur = ((t - t_lo) & 1) * DA_STG, nxt = DA_STG - cur;
            if (t + 1 <= t_hi) { tile_sstore<64, 128>(kr, KS + nxt, tid); tile_sstore<128, 64>(vr, VS + nxt, tid); }
            if (t + 2 <= t_hi) { tile_gload<64, 128>(kr, kt + (size_t)(t + 2) * 64 * ZW, ZW, tid); tile_gload<128, 64>(vr, vt + (size_t)(t + 2) * 64, TG, tid); }
            const float base = (float)(qpos - (t * 64 + 4 * h));
            f32x16 ta, tb_;
            const int side = (t * 64 + 63 < q0) ? 1 : ((t * 64 > q0 + 31) ? -1 : 0);
            if (side != 0) {
                const float ssl = (side > 0) ? slc : -slc;
                const float a0 = __builtin_fmaf(base, ssl, mrc), a1 = __builtin_fmaf(base - 32.f, ssl, mrc);
#pragma unroll
                for (int i = 0; i < 16; ++i) { const float ci = (float)((i & 3) + 8 * (i >> 2)); float x0 = __builtin_fmaf(-ssl, ci, a0), x1 = __builtin_fmaf(-ssl, ci, a1); asm volatile("" : "+v"(x0), "+v"(x1));   ta[i] = x0; tb_[i] = x1; }
            } else {
#pragma unroll
                for (int i = 0; i < 16; ++i) { const float ci = (float)((i & 3) + 8 * (i >> 2)); float x0 = __builtin_fmaf(fabsf(base - ci), slc, mrc), x1 = __builtin_fmaf(fabsf(base - 32.f - ci), slc, mrc); asm volatile("" : "+v"(x0), "+v"(x1)); ta[i] = x0; tb_[i] = x1; }
            }
            f32x16 sa = qk_block<4>(kp + cur, qf, ta);
            f32x16 sb_ = qk_block<4>(kp + cur + 32 * 272, qf, tb_);
            float ls = 0.f;
#pragma unroll
            for (int i = 0; i < 16; ++i) { sa[i] = fexp2(sa[i]); ls += sa[i]; }
            pv_block<4>(o, vp + cur, pack8(sa, 0), pack8(sa, 1));
#pragma unroll
            for (int i = 0; i < 16; ++i) { sb_[i] = fexp2(sb_[i]); ls += sb_[i]; }
            l += ls;
            pv_block<4>(o, vp + cur + 64, pack8(sb_, 0), pack8(sb_, 1));
            __syncthreads();
        }
    } else {
        float m = -INFINITY;
        for (int t = t_lo; t <= t_hi; ++t) {
            __syncthreads(); tile_sstore<64, 128>(kr, KS, tid); tile_sstore<128, 64>(vr, VS, tid); __syncthreads();
            if (t + 1 <= t_hi) { tile_gload<64, 128>(kr, kt + (size_t)(t + 1) * 64 * ZW, ZW, tid); tile_gload<128, 64>(vr, vt + (size_t)(t + 1) * 64, TG, tid); }
#pragma unroll 1
            for (int kb = 0; kb < 2; ++kb) {
                const float base = (float)(qpos - (t * 64 + 32 * kb + 4 * h));
                f32x16 ta;
#pragma unroll
                for (int i = 0; i < 16; ++i) ta[i] = fabsf(base - (float)((i & 3) + 8 * (i >> 2))) * slc;
                f32x16 s = qk_block<4>(kp + kb * 32 * 272, qf, ta);
                softmax_pv<4, false>(s, 1.0f, m, l, o, vp + kb * 64);
            }
        }
    }
    l = xor32_sum(l);
    const float* L = da_lambda + layer * 256;
    const float sa_ = wave_sum(L[lane] * L[64 + lane], lane), sb2 = wave_sum(L[128 + lane] * L[192 + lane], lane);
    const float linit = 0.8f - 0.6f * __expf(-0.3f * (float)layer);
    const float lam = __expf(sa_) - __expf(sb2) + linit;
    LAS float* xo = (LAS float*)(lds + DA_XO) + wr * 4096 + lane;
    __syncthreads();
    if (mp == 1) { const float sc1 = lam / l;
#pragma unroll
        for (int db = 0; db < 4; ++db)
#pragma unroll
            for (int i = 0; i < 16; ++i) xo[(db * 16 + i) * 64] = o[db][i] * sc1; }
    __syncthreads();
    if (mp == 0) {
        const float il = 1.0f / l; float ss = 0.f;
#pragma unroll
        for (int db = 0; db < 4; ++db)
#pragma unroll
            for (int i = 0; i < 16; ++i) { const float v = o[db][i] * il - xo[(db * 16 + i) * 64]; o[db][i] = v; ss += v * v; }
        ss = xor32_sum(ss);
        const float rn = __builtin_amdgcn_rsqf(ss * (1.f / 128.f) + EPS) * (1.0f - linit);
        if (st) store_o<4, true>(o, qrow, rn, da_norm + layer * 128, h);
    }
}

template <bool st> DI void gqa_unit(int b, int hq, int qb, int S, bf16_t* Z, const bf16_t* VT, LAS unsigned char* lds, const unsigned* kcmax_word) {
    int tid_ = threadIdx.x; asm volatile("" : "+v"(tid_));
    const int tid = tid_, lane = tid & 63, r = lane & 31, h = lane >> 5, wid = __builtin_amdgcn_readfirstlane(tid >> 6);
    const int tb = b * S, q0 = qb * 256 + wid * 32, NT = S / 64, kvh = hq >> 2;
    bf16_t* qrow = Z + (size_t)(tb + q0 + r) * ZW + Z_QC + hq * 128;
    bf16x8 qf[8];
    float qn2 = 0.f;
#pragma unroll
    for (int ds = 0; ds < 8; ++ds) { qf[ds] = *(const bf16x8*)(qrow + 16 * ds + 8 * h);
#pragma unroll
        for (int j = 0; j < 8; ++j) { const float x = bf2f((unsigned short)qf[ds][j]); qn2 += x * x; } }
    qn2 = xor32_sum(qn2);
    const bf16_t* kt = Z + (size_t)tb * ZW + Z_KC + kvh * 128;
    const bf16_t* vt = VT + (size_t)(V_C + kvh * 128) * TG + tb;
    LAS unsigned char* KS = lds + AT_KS; LAS unsigned char* VS = lds + AT_VS;
    const LAS unsigned char* kp = KS + r * 272 + 16 * h;
    const LAS unsigned char* vp = VS + r * VSTR_B + 8 * h;
    const float kc2 = __builtin_bit_cast(float, __hip_atomic_load(kcmax_word, __ATOMIC_RELAXED, __HIP_MEMORY_SCOPE_AGENT));
    const float sq = __builtin_sqrtf(qn2 * kc2) * 1.01f;
    const float mref = fminf(sq, 100.f - sq);
    const bool fixed_ref = !__any(sq > 110.f);
    const bool fast = fixed_ref;
    float l = 0.f;
    f32x16 o[4];
#pragma unroll
    for (int db = 0; db < 4; ++db) o[db] = (f32x16){};
    u32x4 kr[2], vr[2];
    tile_gload<64, 128>(kr, kt, ZW, tid); tile_gload<128, 64>(vr, vt, TG, tid);
    if (fast) {
        const float mrc = -mref;
        f32x16 cinit;
#pragma unroll
        for (int i = 0; i < 16; ++i) cinit[i] = mrc;
        for (int t = 0; t < NT; ++t) {
            __syncthreads(); tile_sstore<64, 128>(kr, KS, tid); tile_sstore<128, 64>(vr, VS, tid); __syncthreads();
            if (t + 1 < NT) { tile_gload<64, 128>(kr, kt + (size_t)(t + 1) * 64 * ZW, ZW, tid); tile_gload<128, 64>(vr, vt + (size_t)(t + 1) * 64, TG, tid); }
            f32x16 sa = qk_block<8>(kp, qf, cinit);
            f32x16 sb_ = qk_block<8>(kp + 32 * 272, qf, cinit);
            float ls = 0.f;
#pragma unroll
            for (int i = 0; i < 16; ++i) { sa[i] = fexp2(sa[i]); ls += sa[i]; }
            pv_block<4>(o, vp, pack8(sa, 0), pack8(sa, 1));
#pragma unroll
            for (int i = 0; i < 16; ++i) { sb_[i] = fexp2(sb_[i]); ls += sb_[i]; }
            l += ls;
            pv_block<4>(o, vp + 64, pack8(sb_, 0), pack8(sb_, 1));
        }
    } else {
        float m = -INFINITY;
        for (int t = 0; t < NT; ++t) {
            __syncthreads(); tile_sstore<64, 128>(kr, KS, tid); tile_sstore<128, 64>(vr, VS, tid); __syncthreads();
            if (t + 1 < NT) { tile_gload<64, 128>(kr, kt + (size_t)(t + 1) * 64 * ZW, ZW, tid); tile_gload<128, 64>(vr, vt + (size_t)(t + 1) * 64, TG, tid); }
#pragma unroll
            for (int kb = 0; kb < 2; ++kb) {
                f32x16 s = qk_block<8>(kp + kb * 32 * 272, qf);
                softmax_pv<4, false>(s, 1.0f, m, l, o, vp + kb * 64);
            }
        }
    }
    l = xor32_sum(l);
    if (st) store_o<4, false>(o, qrow, 1.0f / l, nullptr, h);
}

template <bool st> DI void na_unit(int layer, int b, int rp_, int hp, int S, bf16_t* Z, const bf16_t* VT, const float* na_rpb, LAS unsigned char* lds) {
    int tid_ = threadIdx.x; asm volatile("" : "+v"(tid_));
    const int tid = tid_, lane = tid & 63, r = lane & 31, h = lane >> 5, wid = __builtin_amdgcn_readfirstlane(tid >> 6);
    const int hl = wid >> 2, rs = (wid >> 1) & 1, half = wid & 1, head = hp * 2 + hl, rows = S / 64, row = 2 * rp_ + rs;
    const int tb = b * S;
    int start = row - 4; start = start < 0 ? 0 : start; start = start > rows - 8 ? rows - 8 : start;
    int j_lo = 2 * rp_ - 4; j_lo = j_lo < 0 ? 0 : j_lo; j_lo = j_lo > rows - 8 ? rows - 8 : j_lo;
    int j_hi = 2 * rp_ + 1 - 4; j_hi = j_hi < 0 ? 0 : j_hi; j_hi = j_hi > rows - 8 ? rows - 8 : j_hi; j_hi += 7;
    LAS unsigned char* KS = lds + AT_KS; LAS unsigned char* VS = lds + AT_VS; LAS float* RP = (LAS float*)(lds + AT_RPB);
    __syncthreads();
    { const float* src = na_rpb + ((size_t)layer * 16 + hp * 2) * 465;
      for (int i = tid; i < 2 * 465; i += 512) RP[i] = src[i] * LOG2E; }
    bf16_t* qrow = Z + (size_t)(tb + row * 64 + half * 32 + r) * ZW + Z_QN + head * 64;
    bf16x8 qf[4];
#pragma unroll
    for (int ds = 0; ds < 4; ++ds) qf[ds] = *(const bf16x8*)(qrow + 16 * ds + 8 * h);
    const bf16_t* kt = Z + (size_t)tb * ZW + Z_KN + hp * 128;
    const bf16_t* vt = VT + (size_t)(V_N + hp * 128) * TG + tb;
    const LAS unsigned char* kp = KS + r * 272 + (hl * 64 + 8 * h) * 2;
    const LAS unsigned char* vp = VS + (hl * 64 + r) * VSTR_B + 8 * h;
    const int cq = 32 * half + r; int cs = cq - 8; cs = cs < 0 ? 0 : cs; cs = cs > 48 ? 48 : cs;
    float m = -INFINITY, l = 0.f;
    f32x16 o[2]; o[0] = (f32x16){}; o[1] = (f32x16){};
    f32x16 mneg[2]; int boff[2][16];
#pragma unroll
    for (int kb = 0; kb < 2; ++kb)
#pragma unroll
        for (int i = 0; i < 16; ++i) {
            const int ck = 32 * kb + (i & 3) + 8 * (i >> 2) + 4 * h;
            int idx = ck - cq + 15; idx = idx < 0 ? 0 : idx; idx = idx > 30 ? 30 : idx;
            boff[kb][i] = idx * 4;
            mneg[kb][i] = ((ck >= cs) && (ck < cs + 16)) ? 0.f : -INFINITY;
        }
    u32x4 kr[2], vr[2];
    tile_gload<64, 128>(kr, kt + (size_t)j_lo * 64 * ZW, ZW, tid); tile_gload<128, 64>(vr, vt + (size_t)j_lo * 64, TG, tid);
    for (int j = j_lo; j <= j_hi; ++j) {
        __syncthreads(); tile_sstore<64, 128>(kr, KS, tid); tile_sstore<128, 64>(vr, VS, tid); __syncthreads();
        if (j + 1 <= j_hi) { tile_gload<64, 128>(kr, kt + (size_t)(j + 1) * 64 * ZW, ZW, tid); tile_gload<128, 64>(vr, vt + (size_t)(j + 1) * 64, TG, tid); }
        if (j < start || j >= start + 8) continue;
        const int dr = j - row + 7;
        const LAS unsigned char* rpb = (const LAS unsigned char*)(RP + hl * 465 + dr * 31);
#pragma unroll
        for (int kb = 0; kb < 2; ++kb) {
            f32x16 s = qk_block<4>(kp + kb * 32 * 272, qf, mneg[kb]);
#pragma unroll
            for (int i = 0; i < 16; ++i) s[i] += *(const LAS float*)(rpb + boff[kb][i]);
            softmax_pv<2, true>(s, 1.0f, m, l, o, vp + kb * 64);
        }
    }
    l = xor32_sum(l);
    if (st) store_o<2, false>(o, qrow, 1.0f / l, nullptr, h);
}


#define GAS __attribute__((address_space(1)))
#define XB_TMO      128
#define XB_XCNT(j)  (256  + 64 * (j))
#define XB_XSUB(j)  (1280 + 64 * (j))
#define XB_XGEN(j)  (2304 + 64 * (j))
#define XB_TOP      3328
#define XB_TOPGEN   3392
#define XCD_BAR_WORDS 3456
#define XB_SPIN_CAP (1u << 18)

__device__ __forceinline__ unsigned xb_ld(unsigned* p)              { return __hip_atomic_load(p, __ATOMIC_RELAXED, __HIP_MEMORY_SCOPE_AGENT); }
__device__ __forceinline__ unsigned xb_add(unsigned* p, unsigned v) { return __hip_atomic_fetch_add(p, v, __ATOMIC_RELAXED, __HIP_MEMORY_SCOPE_AGENT); }
__device__ __forceinline__ unsigned xb_xcc_id() { return (unsigned)__builtin_amdgcn_s_getreg((3 << 11) | 20) & 0xFu; }
#define XB_SPIN(cond, bar) do { unsigned _sp = 0; while (cond) { __builtin_amdgcn_s_sleep(1); \
    if ((++_sp & 255u) == 0u) { if (xb_ld(&(bar)[XB_TMO])) break; if (_sp > XB_SPIN_CAP) { atomicAdd(&(bar)[XB_TMO], 1u); break; } } } } while (0)

struct XcdBarrier {
    unsigned* bar; unsigned x;
    volatile LAS unsigned* st;
};

__device__ __forceinline__ XcdBarrier xcd_barrier_post(unsigned* bar, volatile LAS unsigned* st) {
    XcdBarrier b; b.bar = bar; b.x = xb_xcc_id(); b.st = st;
    if (threadIdx.x == 0) (void)xb_add(&bar[XB_XCNT(b.x)], 1u);
    return b;
}
__device__ __forceinline__ void xcd_barrier_complete(unsigned* bar, unsigned x, unsigned& nloc, unsigned& nx) {
    const unsigned G = gridDim.x * gridDim.y * gridDim.z;
    unsigned sum, cnt, mine, sp = 0u;
    for (;;) {
        sum = 0u; cnt = 0u; mine = 0u;
#pragma unroll
        for (unsigned j = 0; j < 16; ++j) { const unsigned c = xb_ld(&bar[XB_XCNT(j)]); sum += c; cnt += (c > 0u) ? 1u : 0u; mine = (j == x) ? c : mine; }
        if (sum == G) break;
        __builtin_amdgcn_s_sleep(1);
        if ((++sp & 255u) == 0u) { if (xb_ld(&bar[XB_TMO])) break; if (sp > XB_SPIN_CAP) { atomicAdd(&bar[XB_TMO], 1u); break; } }
    }
    nloc = mine > 0u ? mine : 1u; nx = cnt > 0u ? cnt : 1u;
}

__device__ __forceinline__ void xcd_barrier(const XcdBarrier& b) {
    asm volatile("s_waitcnt vmcnt(0)" ::: "memory");
    __syncthreads();
    if (threadIdx.x == 0) {
        unsigned* bar = b.bar;
        __builtin_amdgcn_s_waitcnt(0);
        unsigned nloc = b.st[0], nx = b.st[1];
        if (nloc == 0u) { xcd_barrier_complete(bar, b.x, nloc, nx); b.st[0] = nloc; b.st[1] = nx; }
        const unsigned old = xb_add(&bar[XB_XSUB(b.x)], 1u);
        const unsigned gen = old / nloc;
        if (old + 1u == (gen + 1u) * nloc) {
            __builtin_amdgcn_fence(__ATOMIC_RELEASE, "agent");
            asm volatile("s_waitcnt vmcnt(0)" ::: "memory");
            const unsigned og = xb_add(&bar[XB_TOP], 1u);
            const unsigned tg = og / nx;
            if (og + 1u == (tg + 1u) * nx) xb_add(&bar[XB_TOPGEN], 1u);
            else XB_SPIN(xb_ld(&bar[XB_TOPGEN]) == tg, bar);
            __builtin_amdgcn_fence(__ATOMIC_ACQUIRE, "agent");
            xb_add(&bar[XB_XGEN(b.x)], 1u);
            asm volatile("s_waitcnt vmcnt(0)" ::: "memory");
        } else {
            XB_SPIN(xb_ld(&bar[XB_XGEN(b.x)]) == gen, bar);
            __builtin_amdgcn_fence(__ATOMIC_ACQUIRE, "agent");
            asm volatile("s_waitcnt vmcnt(0)" ::: "memory");
        }
    }
    __syncthreads();
}


constexpr int QX_W = 3700;
constexpr int QCTR_W = 3616;
constexpr int KCMAX_W = 3632;
constexpr int KMAX_W = 3600;
constexpr int PTAB_OFF = 134144, BARST_OFF = PTAB_OFF + 256, QSLOT_OFF = PTAB_OFF + 272;
DI const float* ld_ptr(LAS unsigned char* lds, int k) {
    int off = PTAB_OFF + 8 * k; asm volatile("" : "+v"(off));
    const unsigned long long v = *(volatile LAS unsigned long long*)(lds + off);
    const unsigned lo = __builtin_amdgcn_readfirstlane((unsigned)v), hi = __builtin_amdgcn_readfirstlane((unsigned)(v >> 32));
    return (const float*)(GAS const float*)(((unsigned long long)hi << 32) | lo);
}
struct Args { const float* in[23]; float* out; unsigned char* ws; };

__global__ void __launch_bounds__(512, 2) fwd_megakernel(Args args) {
    extern __shared__ __attribute__((aligned(16))) unsigned char lds_raw[];
    LAS unsigned char* lds = (LAS unsigned char*)lds_raw;
    cg::grid_group grid = cg::this_grid();
#define GSYNC() do { xcd_barrier(xbar); if (REP_SYNC > 1) xcd_barrier(xbar); } while (0)
    const int wave = __builtin_amdgcn_readfirstlane((int)threadIdx.x >> 6);
    const int G = gridDim.x, gw = blockIdx.x * 8 + wave, NGW = G * 8;
    if (threadIdx.x == 0) {
#pragma unroll
        for (int k = 0; k < 23; ++k) ((LAS unsigned long long*)(lds + PTAB_OFF))[k] = (unsigned long long)args.in[k];
    }
    if (threadIdx.x < 2) ((LAS unsigned*)(lds + BARST_OFF))[threadIdx.x] = 0u;
    __syncthreads();
    XcdBarrier xbar = xcd_barrier_post((unsigned*)(args.ws + WS_CTL), (volatile LAS unsigned*)(lds + BARST_OFF));
#define INP(k) ld_ptr(lds, (k))
#define WS_PTRS() size_t wz_ = 0; asm volatile("" : "+s"(wz_)); unsigned char* ws = args.ws + wz_;     \
    bf16_t* WB = (bf16_t*)(ws + WS_W); bf16_t* Z = (bf16_t*)(ws + WS_Z); bf16_t* VT = (bf16_t*)(ws + WS_VT); bf16_t* U = (bf16_t*)(ws + WS_U); \
    bf16_t* F = (bf16_t*)(ws + WS_F); bf16_t* E = (bf16_t*)(ws + WS_E); bf16_t* UP = (bf16_t*)(ws + WS_UP); bf16_t* HB = (bf16_t*)(ws + WS_HB); bf16_t* PB = (bf16_t*)(ws + WS_PLEB); \
    const bf16_t* WL = WB + (size_t)layer * WL_TOTAL; (void)Z; (void)VT; (void)U; (void)F; (void)E; (void)UP; (void)HB; (void)PB; (void)WL;

    {
        const int layer = 0; WS_PTRS();
        LAS float* scr = (LAS float*)(lds + wave * 16640);
        int tid_ = threadIdx.x; asm volatile("" : "+v"(tid_)); const int lane = tid_ & 63;
        int per_layer = 0;
#pragma unroll
        for (int sg_ = 0; sg_ < NSEG; ++sg_) { const Seg q = get_seg(sg_); per_layer += (q.K / 64) * (q.ncols / 64); }
        for (int g = gw; g < DEPTH * per_layer; g += NGW) {
            const int lyr = g / per_layer; int rem = g - lyr * per_layer, si = 0;
#pragma unroll 1
            for (; si < NSEG - 1; ++si) { const Seg q = get_seg(si); const int n = (q.K / 64) * (q.ncols / 64); if (rem < n) break; rem -= n; }
            const Seg sg = get_seg(si);
            const float* W = INP(sg.in) + (size_t)lyr * sg.K * sg.ldw;
            bf16_t* WT = WB + (size_t)lyr * WL_TOTAL + sg.woff;
            const int nbk = sg.ncols / 64;
            transpose_item(W, sg.ldw, sg.col0, sg.K, WT, sg.ldt, sg.drow0, sg.dcol0, scr, rem / nbk, rem % nbk, lane, sg.scale);
        }
    }
    grid.sync();

    for (int grp = 0; grp < 2; ++grp) {
        const int S = grp ? 8192 : 2048;
        float* hbuf = args.out + (size_t)grp * TG * DM;
        { const int layer = 0; WS_PTRS(); row_phase<true, false>(INP(grp), nullptr, nullptr, ws + WS_H16, INP(14), U, gw, NGW); }
        GSYNC();
        for (int layer = 0; layer < DEPTH; ++layer) {
            { WS_PTRS();
              run_gemm_inproj(lds, U, WL + WL_IN, Z, VT); }
            GSYNC();
            { WS_PTRS(); rope_phase(Z, INP(8) + layer * 128, INP(9) + layer * 128, S, gw, NGW, (unsigned*)(ws + WS_CTL) + KMAX_W + grp * 4 + layer, (unsigned*)(ws + WS_CTL) + KCMAX_W + grp * 4 + layer); }
            GSYNC();
            {
                WS_PTRS();
                const int nqb = S / 256, rows = S / 64;
                unsigned* qctr = (unsigned*)(ws + WS_CTL) + QX_W + (grp * 4 + layer) * 8;
                volatile LAS int* slot = (volatile LAS int*)(lds + QSLOT_OFF);
                const int myq = (int)(xbar.x & 7u);
                int qi = 0;
                for (;;) {
                    __syncthreads();
                    if (threadIdx.x == 0) {
                        int got = -1;
                        while (qi < 8) { const int q = (myq + qi) & 7; const unsigned p = __hip_atomic_fetch_add(qctr + q, 1u, __ATOMIC_RELAXED, __HIP_MEMORY_SCOPE_AGENT);
                            if (p < 320u) { got = q * 320 + (int)p; break; } ++qi; }
                        *slot = got;
                    }
                    __syncthreads();
                    const int u = __builtin_amdgcn_readfirstlane(*slot);
                    if (u < 0) break;
                    const int q = u / 320, p = u - q * 320;
                    if (p < 64) {
                        int b, hq, qb;
                        if (grp) { const int set = q >> 1, kvh = set & 1; b = set >> 1; hq = kvh * 4 + (q & 1) * 2 + (p >> 5); qb = p & 31; }
                        else { const int set = 2 * q + (p >> 5), kvh = set & 1, jj = p & 31; b = set >> 1; hq = kvh * 4 + (jj >> 3); qb = jj & 7; }
                        gqa_unit<true>(b, hq, qb, S, Z, VT, lds, (const unsigned*)(ws + WS_CTL) + KCMAX_W + grp * 4 + layer); }
                    else if (p < 192) {
                        const int idx = p - 64; int b, hd, qb;
                        if (grp) { const bool first = idx < 64, heavy_b0 = q >= 4, use_b0 = (first == heavy_b0); b = use_b0 ? 0 : 1; hd = use_b0 ? q : 7 - q; qb = idx & 63; }
                        else { hd = 7 - (idx >> 4); b = (hd - q) & 7; qb = idx & 15; }
                        const unsigned* kw = (const unsigned*)(ws + WS_CTL) + KMAX_W + grp * 4 + layer;
                        da_unit<true>(layer, b, hd, qb, S, Z, VT, INP(5), INP(6), lds, kw); }
                    else { const int i = p - 192, hp = q, rp_ = i % (rows / 2), b = i / (rows / 2); na_unit<true>(layer, b, rp_, hp, S, Z, VT, INP(7), lds); }
                }
                __syncthreads();
            }
            GSYNC();
            { WS_PTRS(); run_gemm_branch(lds, Z, WL + WL_BR); }
            GSYNC();
            { WS_PTRS(); run_gemm<0>(lds, Z + Z_GZ, ZW, WL + WL_O3, DM, TG, DM, DM, F, DM, nullptr, 0); }
            GSYNC();
            { WS_PTRS();
              row_phase<false, false>(ws + WS_H16, F, INP(15) + layer * DM, ws + WS_H16, INP(16) + layer * DM, U, gw, NGW);
              ple_phase(INP(2 + grp) + (size_t)layer * TG * PLED, PB, gw, NGW); }
            GSYNC();
            { WS_PTRS();
              run_gemm<2>(lds, U, DM, WL + WL_UP, DM, TG, DFF, DM, UP, DFF, nullptr, 0);
              run_gemm<0>(lds, PB, PLED, WL + WL_PL, PLED, TG, DM, PLED, E, DM, nullptr, 0); }
            GSYNC();
            { WS_PTRS(); run_gemm<0>(lds, UP, DFF, WL + WL_DN, DFF, TG, DM, DFF, F, DM, nullptr, 0); }
            GSYNC();
            { WS_PTRS(); row_phase<false, false>(ws + WS_H16, F, INP(17) + layer * DM, ws + WS_H16, nullptr, nullptr, gw, NGW); }
            GSYNC();
            { WS_PTRS(); run_gemm<3>(lds, (const bf16_t*)(ws + WS_H16), DM, WL + WL_PG, DM, TG, DM, DM, E, DM, E, DM); }
            GSYNC();
            { WS_PTRS();
              if (layer + 1 < DEPTH) row_phase<false, false>(ws + WS_H16, E, INP(22) + layer * DM, ws + WS_H16, INP(14) + (layer + 1) * DM, U, gw, NGW);
              else row_phase<false, true>(ws + WS_H16, E, INP(22) + layer * DM, hbuf, nullptr, nullptr, gw, NGW); }
            GSYNC();
        }
    }
#undef WS_PTRS
#undef INP
}

extern "C" void kernel_launch(void* const* d_in, const int* in_sizes, int n_in, void* d_out, int out_size, void* d_ws, size_t ws_size, hipStream_t stream) {
    static int grid = 0;
    if (grid == 0) {
        if (n_in != 23 || ws_size < WS_END || out_size != 2 * TG * DM) { fprintf(stderr, "kernel_launch: unexpected problem (n_in %d, ws %zu, out %d)\n", n_in, ws_size, out_size); grid = -1; return; }
        int dev = 0, cus = 0, per_cu = 0;
        (void)hipGetDevice(&dev);
        (void)hipDeviceGetAttribute(&cus, hipDeviceAttributeMultiprocessorCount, dev);
        if (hipFuncSetAttribute((const void*)fwd_megakernel, hipFuncAttributeMaxDynamicSharedMemorySize, LDS_BYTES) != hipSuccess) { fprintf(stderr, "kernel_launch: hipFuncSetAttribute failed\n"); grid = -1; return; }
        if (hipOccupancyMaxActiveBlocksPerMultiprocessor(&per_cu, (const void*)fwd_megakernel, 512, LDS_BYTES) != hipSuccess || per_cu < 1) { fprintf(stderr, "kernel_launch: occupancy query gives %d\n", per_cu); per_cu = 1; }
        (void)hipGetLastError();
        grid = cus * 1;
        if (grid <= 0) { grid = -1; return; }
    }
    if (grid < 0) return;
    (void)hipMemsetAsync((char*)d_ws + WS_CTL, 0, CTL_BYTES, stream);
    Args a{};
    for (int i = 0; i < 23; ++i) a.in[i] = (const float*)d_in[i];
    a.out = (float*)d_out; a.ws = (unsigned char*)d_ws;
    void* kargs[] = {&a};
    hipError_t e = hipLaunchCooperativeKernel((const void*)fwd_megakernel, dim3(grid), dim3(512), kargs, LDS_BYTES, stream);
    if (e != hipSuccess) fprintf(stderr, "kernel_launch: cooperative launch failed: %s (grid %d)\n", hipGetErrorString(e), grid);
}
```

```cpp
#include <hip/hip_runtime.h>
#include <hip/hip_cooperative_groups.h>
#include <cstdio>
#include <cstdint>
namespace cg = cooperative_groups;
#define REP_DA 1
#define REP_GQA 1
#define REP_SYNC 1
#define REP_NA 1

#define LAS __attribute__((address_space(3)))
#define DI __device__ __forceinline__
typedef unsigned short bf16_t;
typedef short bf16x8 __attribute__((ext_vector_type(8)));
typedef short s16x4 __attribute__((ext_vector_type(4)));
typedef float f32x4 __attribute__((ext_vector_type(4)));
typedef float f32x16 __attribute__((ext_vector_type(16)));
typedef unsigned u32x4 __attribute__((ext_vector_type(4)));
typedef unsigned u32x2 __attribute__((ext_vector_type(2)));
typedef float f32x2_t __attribute__((ext_vector_type(2)));
typedef __bf16 bf16x2_t __attribute__((ext_vector_type(2)));

constexpr int DM = 1024, DEPTH = 4, TG = 16384, DFF = 4096, PLED = 256, INW = 10752;
constexpr int ZW = 8448, VW = 2304;
constexpr int Z_QA = 0, Z_KA = 1024, Z_QN = 2048, Z_KN = 3072, Z_QC = 4096, Z_KC = 5120, Z_GZ = 5376;
constexpr int V_A = 0, V_N = 1024, V_C = 2048;
constexpr float EPS = 1e-6f, LOG2E = 1.4426950408889634f;
constexpr size_t WL_IN = 0, WL_BR = WL_IN + (size_t)INW * DM, WL_O3 = WL_BR + (size_t)3072 * DM, WL_UP = WL_O3 + (size_t)DM * 3072,
                 WL_DN = WL_UP + (size_t)DFF * DM, WL_PL = WL_DN + (size_t)DM * DFF, WL_PG = WL_PL + (size_t)DM * PLED, WL_TOTAL = WL_PG + (size_t)DM * DM;
constexpr size_t MiB = 1u << 20;
constexpr size_t WS_W = 0, WS_Z = 208 * MiB, WS_VT = 472 * MiB, WS_U = 544 * MiB, WS_CTL = 576 * MiB, CTL_BYTES = 16384, WS_H16 = 578 * MiB, WS_END = 610 * MiB;
static_assert(WL_TOTAL * 2 * DEPTH <= WS_Z, "weights fit");
static_assert((size_t)TG * ZW * 2 == 264 * MiB && (size_t)VW * TG * 2 == 72 * MiB, "sizes");
constexpr size_t WS_F = WS_VT, WS_E = WS_VT + 32 * MiB, WS_UP = WS_Z, WS_HB = WS_Z + 128 * MiB, WS_PLEB = WS_Z + 160 * MiB;
constexpr int LDS_BYTES = 135168;

DI unsigned cvtpk(float lo, float hi) { f32x2_t v = {lo, hi}; bf16x2_t b = __builtin_convertvector(v, bf16x2_t); return __builtin_bit_cast(unsigned, b); }
DI float bf2f(unsigned short u) { return __builtin_bit_cast(float, (unsigned)u << 16); }
DI float bflo(unsigned u) { return __builtin_bit_cast(float, u << 16); }
DI float bfhi(unsigned u) { return __builtin_bit_cast(float, u & 0xffff0000u); }
DI void swap32(unsigned& a, unsigned& b) { asm volatile("s_nop 1\n\tv_permlane32_swap_b32 %0, %1\n\ts_nop 1" : "+v"(a), "+v"(b)); }
DI float xor32_max(float v) { unsigned a = __builtin_bit_cast(unsigned, v), b = a; swap32(a, b); return fmaxf(__builtin_bit_cast(float, a), __builtin_bit_cast(float, b)); }
DI float xor32_sum(float v) { unsigned a = __builtin_bit_cast(unsigned, v), b = a; swap32(a, b); return __builtin_bit_cast(float, a) + __builtin_bit_cast(float, b); }
template <int CTRL> DI float dpp_sum_step(float v) {
    return v + __builtin_bit_cast(float, __builtin_amdgcn_update_dpp(0, __builtin_bit_cast(int, v), CTRL, 0xF, 0xF, true));
}
DI float wave_sum(float v, int lane) {
    v = dpp_sum_step<0xB1>(v);
    v = dpp_sum_step<0x4E>(v);
    v = dpp_sum_step<0x141>(v);
    v = dpp_sum_step<0x140>(v);
    v += __builtin_bit_cast(float, __builtin_amdgcn_ds_bpermute((lane ^ 16) << 2, __builtin_bit_cast(int, v)));
    return xor32_sum(v);
}
DI float fexp2(float x) { return __builtin_amdgcn_exp2f(x); }
DI float sigmoidf_(float x) { return __builtin_amdgcn_rcpf(1.0f + fexp2(-x * LOG2E)); }

namespace pg8 {
constexpr int BM = 256, BK = 64, HALF = 128, HTB = HALF * BK * 2, STAGE_BYTES = 8 * HTB, NXCD = 8, WGM = 8;
__host__ __device__ __forceinline__ int lds_byte(int r, int c) { const int st = (r >> 4) * 2 + (c >> 5), rr = r & 15, cc = c & 31, ob = rr * 64 + cc * 2; return st * 1024 + (ob ^ (((ob >> 9) & 1) << 5)); }
__host__ __device__ __forceinline__ void stage_rc(int b, int& R, int& C) { const int st = b / 1024, sb = b % 1024, swz = sb ^ (((sb >> 9) & 1) << 5); R = (st >> 1) * 16 + swz / 64; C = (st & 1) * 32 + (swz % 64) / 2; }
__host__ __device__ __forceinline__ int perm32(int rho) { const int n = rho >> 4, i = rho & 15; return 8 * (i >> 2) + 4 * n + (i & 3); }

struct Unit { int pm, pn, sel; };
struct Gemm { const bf16_t* A; const bf16_t* Bt; int M, N, K, lda, ldb, a_shift; size_t a_stride; const bf16_t* A2; const bf16_t* Bt2; };

struct StaticOrder {
    int nM, nN, nwg, G, c;
    __host__ __device__ void init(int M, int N, int G_, int c_) { nM = M / BM; nN = N / BM; nwg = nM * nN; G = G_; c = c_; }
    __host__ __device__ bool next(int i, Unit& u) const { const int L = i * G + c; if (L >= nwg) return false; map(L, u); return true; }
    __host__ __device__ void map(int L, Unit& u) const {
        u.sel = 0;
        int wgid = L; { const int q = nwg / NXCD, r = nwg % NXCD, xcd = wgid % NXCD, off = wgid / NXCD; wgid = (xcd < r ? xcd * (q + 1) : r * (q + 1) + (xcd - r) * q) + off; }
        const int nig = WGM * nN, gid = wgid / nig, fm = gid * WGM, gsz = (nM - fm) < WGM ? (nM - fm) : WGM;
        u.pm = fm + ((wgid % nig) % gsz); u.pn = (wgid % nig) / gsz;
    }
};
struct DualOrder {
    StaticOrder a, b; int G, c;
    __host__ __device__ void init(int M1, int N1, int M2, int N2, int G_, int c_) { a.init(M1, N1, G_, c_); b.init(M2, N2, G_, c_); G = G_; c = c_; }
    __host__ __device__ bool next(int i, Unit& u) const {
        const int L = i * G + c;
        if (L < a.nwg) { a.map(L, u); return true; }
        if (L < a.nwg + b.nwg) { b.map(L - a.nwg, u); u.sel = 1; return true; }
        return false;
    }
};

template <int MODE> struct Epi {
    bf16_t* O; int ldc; const bf16_t* X; int ldx;
    DI void operator()(const f32x4 (&acc)[2][2][4][2], const Unit& u, int wr, int wc, int fr, int fq) const {
        const int row0 = u.pm * BM + wr * 64 + fr, col0 = u.pn * BM + wc * 32 + 8 * fq;
        if (MODE == 4) { if ((u.pn >> 2) != 0) __builtin_amdgcn_fence(__ATOMIC_ACQUIRE, "agent"); }
#pragma unroll
        for (int ai = 0; ai < 2; ++ai)
#pragma unroll
            for (int m = 0; m < 4; ++m) {
                const size_t r = (size_t)(row0 + ai * HALF + m * 16);
#pragma unroll
                for (int bj = 0; bj < 2; ++bj) {
                    const int c = col0 + bj * HALF;
                    f32x4 v0 = acc[ai][bj][m][0], v1 = acc[ai][bj][m][1];
                    if (MODE == 1 || MODE == 3) {
                        const u32x4 xv = *(const u32x4*)(X + r * ldx + c);
                        const float x0 = bflo(xv.x), x1 = bfhi(xv.x), x2 = bflo(xv.y), x3 = bfhi(xv.y), x4 = bflo(xv.z), x5 = bfhi(xv.z), x6 = bflo(xv.w), x7 = bfhi(xv.w);
                        if (MODE == 1) {
                            v0 = (f32x4){v0[0] * sigmoidf_(x0), v0[1] * sigmoidf_(x1), v0[2] * sigmoidf_(x2), v0[3] * sigmoidf_(x3)};
                            v1 = (f32x4){v1[0] * sigmoidf_(x4), v1[1] * sigmoidf_(x5), v1[2] * sigmoidf_(x6), v1[3] * sigmoidf_(x7)};
                        } else {
                            v0 = (f32x4){x0 * sigmoidf_(v0[0]), x1 * sigmoidf_(v0[1]), x2 * sigmoidf_(v0[2]), x3 * sigmoidf_(v0[3])};
                            v1 = (f32x4){x4 * sigmoidf_(v1[0]), x5 * sigmoidf_(v1[1]), x6 * sigmoidf_(v1[2]), x7 * sigmoidf_(v1[3])};
                        }
                    }
                    if (MODE == 4) {
                        const int jgrp = u.pn >> 2;
                        const u32x4 xv = *(const u32x4*)(X + r * ldx + c);
                        v0 = (f32x4){v0[0] * sigmoidf_(bflo(xv.x)), v0[1] * sigmoidf_(bfhi(xv.x)), v0[2] * sigmoidf_(bflo(xv.y)), v0[3] * sigmoidf_(bfhi(xv.y))};
                        v1 = (f32x4){v1[0] * sigmoidf_(bflo(xv.z)), v1[1] * sigmoidf_(bfhi(xv.z)), v1[2] * sigmoidf_(bflo(xv.w)), v1[3] * sigmoidf_(bfhi(xv.w))};
                        bf16_t* op = O + r * ldc + (c - 1024 * jgrp);
                        if (jgrp) { const u32x4 pv = *(const u32x4*)op;
                            v0 = v0 + (f32x4){bflo(pv.x), bfhi(pv.x), bflo(pv.y), bfhi(pv.y)}; v1 = v1 + (f32x4){bflo(pv.z), bfhi(pv.z), bflo(pv.w), bfhi(pv.w)}; }
                        u32x4 w; w.x = cvtpk(v0[0], v0[1]); w.y = cvtpk(v0[2], v0[3]); w.z = cvtpk(v1[0], v1[1]); w.w = cvtpk(v1[2], v1[3]);
                        *(u32x4*)op = w;
                        continue;
                    }
                    if (MODE == 2) {
#pragma unroll
                        for (int e = 0; e < 4; ++e) { const float a = fmaxf(v0[e], 0.f), b = fmaxf(v1[e], 0.f); v0[e] = a * a; v1[e] = b * b; }
                    }
                    u32x4 w; w.x = cvtpk(v0[0], v0[1]); w.y = cvtpk(v0[2], v0[3]); w.z = cvtpk(v1[0], v1[1]); w.w = cvtpk(v1[2], v1[3]);
                    if (MODE == 5 && u.sel) *(u32x4*)((bf16_t*)X + r * ldx + c) = w;
                    else *(u32x4*)(O + r * ldc + c) = w;
                }
            }
    }
};

struct BranchOrder {
    StaticOrder base;
    __host__ __device__ void init(int M, int G_, int c_) { base.init(M, 1024, G_, c_); }
    __host__ __device__ bool next(int i, Unit& u) const {
        const int ti = i / 3, j = i - 3 * ti; Unit t;
        if (!base.next(ti, t)) return false;
        u.pm = t.pm; u.pn = j * 4 + t.pn; u.sel = 0; return true;
    }
};
template <class EpiT, bool ALIGN_EPI, class Sched>
DI void gemm_phase(LAS unsigned char* lds, const Gemm g, const Sched& S, const EpiT& E) {
    int tid_ = threadIdx.x; asm volatile("" : "+v"(tid_));
    const int tid = tid_, wid = __builtin_amdgcn_readfirstlane(tid >> 6), lane = tid & 63, wr = wid >> 2, wc = wid & 3, fr = lane & 15, fq = lane >> 4;
    const int K = g.K, nt = K / BK;
    unsigned voffA[2], voffB[2];
#pragma unroll
    for (int i = 0; i < 2; ++i) { int R, C; stage_rc(tid * 16 + i * 8192, R, C); const int Rb = (R & ~31) + perm32(R & 31);
        voffA[i] = (unsigned)(R * g.lda + C) * 2u; voffB[i] = (unsigned)(Rb * g.ldb + C) * 2u; }
    const size_t kstep = (size_t)(BK * 2);
    const size_t hstepA = (size_t)HALF * g.lda * 2, hstepB = (size_t)HALF * g.ldb * 2;
    const size_t tstepA = 2 * hstepA, tstepB = 2 * hstepB;
    const unsigned ldsw = (unsigned)wid * 1024u;
    const int aoff = lds_byte(wr * 64 + fr, fq * 8), boff = lds_byte(wc * 32 + fr, fq * 8);
#define PG8_SA(b, h) (((b) * 2 + (h)) * HTB)
#define PG8_SB(b, h) ((4 + (b) * 2 + (h)) * HTB)
#define PG8_STAGE(bufoff, gbase, voff) do { _Pragma("unroll") for (int _i = 0; _i < 2; ++_i) \
        __builtin_amdgcn_global_load_lds((const unsigned*)((const char*)(gbase) + (voff)[_i]), (LAS unsigned*)(lds + (bufoff) + ldsw + _i * 8192), 16, 0, 0); } while (0)
#define PG8_LDA(dst, b, h) do { _Pragma("unroll") for (int m = 0; m < 4; ++m) _Pragma("unroll") for (int k = 0; k < 2; ++k) dst[m][k] = *(const LAS bf16x8*)(lds + PG8_SA(b, h) + aoff + m * 2048 + k * 1024); } while (0)
#define PG8_LDB(dst, b, h) do { _Pragma("unroll") for (int n = 0; n < 2; ++n) _Pragma("unroll") for (int k = 0; k < 2; ++k) dst[n][k] = *(const LAS bf16x8*)(lds + PG8_SB(b, h) + boff + n * 2048 + k * 1024); } while (0)
#define PG8_MMA(ai, bj, At, Bt) do { __builtin_amdgcn_s_setprio(1); _Pragma("unroll") for (int m = 0; m < 4; ++m) _Pragma("unroll") for (int n = 0; n < 2; ++n) _Pragma("unroll") for (int k = 0; k < 2; ++k) \
        acc[ai][bj][m][n] = __builtin_amdgcn_mfma_f32_16x16x32_bf16(Bt[n][k], At[m][k], acc[ai][bj][m][n], 0, 0, 0); __builtin_amdgcn_s_setprio(0); } while (0)
#define PG8_WAIT_V(n) asm volatile("s_waitcnt vmcnt(" #n ")" ::: "memory")
#define PG8_WAIT_L(n) asm volatile("s_waitcnt lgkmcnt(" #n ")" ::: "memory")
#define PG8_BAR __builtin_amdgcn_s_barrier()
#define PG8_SCHED __builtin_amdgcn_sched_barrier(0)
#define PG8_AOF(u) ((const char*)((u).sel ? g.A2 : g.A) + (size_t)(u).pm * tstepA + (size_t)((u).pn >> g.a_shift) * g.a_stride)
#define PG8_BOF(u) ((const char*)((u).sel ? g.Bt2 : g.Bt) + (size_t)(u).pn * tstepB)
    Unit cur, nxt; int ui = 0;
    if (!S.next(0, cur)) return;
    f32x4 acc[2][2][4][2];
#pragma unroll
    for (int a = 0; a < 2; ++a)
#pragma unroll
        for (int b = 0; b < 2; ++b)
#pragma unroll
            for (int m = 0; m < 4; ++m)
#pragma unroll
                for (int n = 0; n < 2; ++n) acc[a][b][m][n] = (f32x4){0.f, 0.f, 0.f, 0.f};
    bf16x8 At[4][2], B0[2][2], B1[2][2];
    const char* cA = PG8_AOF(cur); const char* cB = PG8_BOF(cur);
    PG8_STAGE(PG8_SB(0, 0), cB, voffB); PG8_STAGE(PG8_SB(0, 1), cB + hstepB, voffB); PG8_STAGE(PG8_SA(0, 0), cA, voffA); PG8_STAGE(PG8_SA(0, 1), cA + hstepA, voffA);
    if (wr == 1) PG8_BAR;
    PG8_WAIT_V(2); PG8_BAR;
    PG8_STAGE(PG8_SB(1, 0), cB + kstep, voffB); PG8_STAGE(PG8_SA(1, 0), cA + kstep, voffA); PG8_STAGE(PG8_SB(1, 1), cB + hstepB + kstep, voffB);
    PG8_WAIT_V(6); PG8_BAR;
    for (;;) {
        const bool has_next = S.next(ui + 1, nxt);
        const char* nA = has_next ? PG8_AOF(nxt) : cA; const char* nB = has_next ? PG8_BOF(nxt) : cB;
        for (int t = 0; t < nt; t += 2) {
            const bool last = (t == nt - 2);
            const char* a1 = cA + (size_t)(t + 1) * kstep;
            const char* a2 = last ? nA : cA + (size_t)(t + 2) * kstep; const char* b2 = last ? nB : cB + (size_t)(t + 2) * kstep;
            const char* a3 = a2 + kstep; const char* b3 = b2 + kstep;
            PG8_LDB(B0, 0, 0); PG8_LDB(B1, 0, 1); PG8_SCHED; PG8_LDA(At, 0, 0); PG8_STAGE(PG8_SA(1, 1), a1 + hstepA, voffA);
            PG8_WAIT_V(8); PG8_WAIT_L(0); PG8_BAR; PG8_MMA(0, 0, At, B0); PG8_MMA(0, 1, At, B1); PG8_BAR; PG8_SCHED;
            PG8_LDA(At, 0, 1); PG8_STAGE(PG8_SB(0, 0), b2, voffB); PG8_STAGE(PG8_SB(0, 1), b2 + hstepB, voffB); PG8_STAGE(PG8_SA(0, 0), a2, voffA);
            PG8_WAIT_V(8); PG8_WAIT_L(0); PG8_BAR; PG8_MMA(1, 0, At, B0); PG8_MMA(1, 1, At, B1); PG8_BAR; PG8_SCHED;
            PG8_LDB(B0, 1, 0); PG8_LDB(B1, 1, 1); PG8_SCHED; PG8_LDA(At, 1, 0); PG8_STAGE(PG8_SA(0, 1), a2 + hstepA, voffA);
            PG8_WAIT_V(8); PG8_WAIT_L(0); PG8_BAR; PG8_MMA(0, 0, At, B0); PG8_MMA(0, 1, At, B1); PG8_BAR; PG8_SCHED;
            PG8_LDA(At, 1, 1); PG8_STAGE(PG8_SB(1, 0), b3, voffB); PG8_STAGE(PG8_SB(1, 1), b3 + hstepB, voffB); PG8_STAGE(PG8_SA(1, 0), a3, voffA);
            PG8_WAIT_V(8); PG8_WAIT_L(0); PG8_BAR; PG8_MMA(1, 0, At, B0); PG8_MMA(1, 1, At, B1); PG8_BAR; PG8_SCHED;
        }
        if constexpr (ALIGN_EPI) { if (wr == 0) PG8_BAR; }
        E(acc, cur, wr, wc, fr, fq);
        if (!has_next) break;
#pragma unroll
        for (int a = 0; a < 2; ++a)
#pragma unroll
            for (int b = 0; b < 2; ++b)
#pragma unroll
                for (int m = 0; m < 4; ++m)
#pragma unroll
                    for (int n = 0; n < 2; ++n) acc[a][b][m][n] = (f32x4){0.f, 0.f, 0.f, 0.f};
        cur = nxt; cA = nA; cB = nB; ++ui;
        if constexpr (ALIGN_EPI) { if (wr == 1) PG8_BAR; }
    }
    PG8_WAIT_V(0);
    if constexpr (!ALIGN_EPI) { if (wr == 0) PG8_BAR; }
    PG8_BAR;
#undef PG8_SA
#undef PG8_SB
#undef PG8_STAGE
#undef PG8_LDA
#undef PG8_LDB
#undef PG8_MMA
#undef PG8_WAIT_V
#undef PG8_WAIT_L
#undef PG8_BAR
#undef PG8_SCHED
#undef PG8_AOF
#undef PG8_BOF
}
}

template <int MODE>
DI void run_gemm(LAS unsigned char* lds, const bf16_t* A, int lda, const bf16_t* Bt, int ldb, int M, int N, int K, bf16_t* O, int ldc, const bf16_t* X, int ldx,
                 int a_shift = 0, size_t a_stride = 0) {
    pg8::Gemm g{A, Bt, M, N, K, lda, ldb, a_shift, a_stride, A, Bt};
    int G_ = (int)gridDim.x, c_ = (int)blockIdx.x; asm volatile("" : "+s"(G_), "+s"(c_));
    pg8::StaticOrder S; S.init(M, N, G_, c_);
    pg8::Epi<MODE> E{O, ldc, X, ldx};
    pg8::gemm_phase<pg8::Epi<MODE>, true, pg8::StaticOrder>(lds, g, S, E);
    __syncthreads();
}
DI void run_gemm_inproj(LAS unsigned char* lds, const bf16_t* U, const bf16_t* Win, bf16_t* Z, bf16_t* VT) {
    pg8::Gemm g{U, Win, TG, ZW, DM, DM, DM, 0, 0, Win + (size_t)ZW * DM, U};
    int G_ = (int)gridDim.x, c_ = (int)blockIdx.x; asm volatile("" : "+s"(G_), "+s"(c_));
    pg8::DualOrder S; S.init(TG, ZW, VW, TG, G_, c_);
    pg8::Epi<5> E{Z, ZW, VT, TG};
    pg8::gemm_phase<pg8::Epi<5>, true, pg8::DualOrder>(lds, g, S, E);
    __syncthreads();
}
DI void run_gemm_branch(LAS unsigned char* lds, bf16_t* Z, const bf16_t* Wbr) {
    pg8::Gemm g{Z, Wbr, TG, 3072, DM, ZW, DM, 2, (size_t)2048 * 2, Z, Wbr};
    int G_ = (int)gridDim.x, c_ = (int)blockIdx.x; asm volatile("" : "+s"(G_), "+s"(c_));
    pg8::BranchOrder S; S.init(TG, G_, c_);
    pg8::Epi<4> E{Z + Z_GZ, ZW, Z + Z_GZ, ZW};
    pg8::gemm_phase<pg8::Epi<4>, true, pg8::BranchOrder>(lds, g, S, E);
    __syncthreads();
}

DI void transpose_item(const float* W, int ldw, int col0, int K, bf16_t* WT, int ldt, int drow0, int dcol0, LAS float* scr, int kb, int nb, int lane, float sc) {
    const int k0 = 64 * kb, n0 = 64 * nb, c = lane & 15, kr = lane >> 4;
    f32x4 v[16];
    const float* src = W + (size_t)(k0 + kr) * ldw + col0 + n0 + 4 * c;
#pragma unroll
    for (int i = 0; i < 16; ++i) v[i] = *(const f32x4*)(src + (size_t)(4 * i) * ldw);
#pragma unroll
    for (int i = 0; i < 16; ++i) { LAS float* d = scr + (4 * c) * 65 + 4 * i + kr; d[0] = v[i].x; d[65] = v[i].y; d[130] = v[i].z; d[195] = v[i].w; }
    asm volatile("s_waitcnt lgkmcnt(0)" ::: "memory");
    const int ch = lane & 7;
#pragma unroll
    for (int j = 0; j < 8; ++j) { const int n = (lane >> 3) + 8 * j; const LAS float* s = scr + n * 65 + 8 * ch;
        u32x4 o; o.x = cvtpk(s[0] * sc, s[1] * sc); o.y = cvtpk(s[2] * sc, s[3] * sc); o.z = cvtpk(s[4] * sc, s[5] * sc); o.w = cvtpk(s[6] * sc, s[7] * sc);
        *(u32x4*)(WT + (size_t)(drow0 + n0 + n) * ldt + dcol0 + k0 + 8 * ch) = o; }
    asm volatile("s_waitcnt lgkmcnt(0)" ::: "memory");
}

constexpr float QSC64 = 0.125f * LOG2E;
struct Seg { int in, ldw, col0, ncols, K, ldt, drow0, dcol0; size_t woff; float scale; };
DI Seg get_seg(int s) {
    switch (s) {
    case 0:  return Seg{4, INW, 0, 1024, DM, DM, 0, 0, WL_IN, QSC64};
    case 1:  return Seg{4, INW, 1024, 1024, DM, DM, 1024, 0, WL_IN, 1.f};
    case 2:  return Seg{4, INW, 3072, 1024, DM, DM, 2048, 0, WL_IN, QSC64};
    case 3:  return Seg{4, INW, 4096, 1024, DM, DM, 3072, 0, WL_IN, 1.f};
    case 4:  return Seg{4, INW, 6144, 1280, DM, DM, 4096, 0, WL_IN, 1.f};
    case 5:  return Seg{4, INW, 7680, 3072, DM, DM, 5376, 0, WL_IN, 1.f};
    case 6:  return Seg{4, INW, 2048, 1024, DM, DM, 8448, 0, WL_IN, 1.f};
    case 7:  return Seg{4, INW, 5120, 1024, DM, DM, 9472, 0, WL_IN, 1.f};
    case 8:  return Seg{4, INW, 7424, 256, DM, DM, 10496, 0, WL_IN, 1.f};
    case 9:  return Seg{10, DM, 0, DM, DM, DM, 0, 0, WL_BR, 1.f};
    case 10: return Seg{11, DM, 0, DM, DM, DM, 1024, 0, WL_BR, 1.f};
    case 11: return Seg{12, DM, 0, DM, DM, DM, 2048, 0, WL_BR, 1.f};
    case 12: return Seg{13, DM, 0, DM, DM, DM, 0, 0, WL_O3, 1.f};
    case 13: return Seg{18, DFF, 0, DFF, DM, DM, 0, 0, WL_UP, 1.f};
    case 14: return Seg{19, DM, 0, DM, DFF, DFF, 0, 0, WL_DN, 1.f};
    case 15: return Seg{20, DM, 0, DM, PLED, PLED, 0, 0, WL_PL, 1.f};
    default: return Seg{21, DM, 0, DM, DM, DM, 0, 0, WL_PG, 1.f};
    }
}
constexpr int NSEG = 17;

template <bool HIN_F32, bool HOUT_F32>
DI void row_phase(const void* hin_, const bf16_t* F, const float* gpost, void* hout_, const float* gnext, bf16_t* U, int gw, int NGW) {
    int tid_ = threadIdx.x; asm volatile("" : "+v"(tid_)); const int lane = tid_ & 63;
    constexpr int RB = 4;
    for (int m0 = gw; m0 < TG; m0 += RB * NGW) {
        f32x4 v[RB][4]; u32x2 fw[RB][4];
#pragma unroll
        for (int k = 0; k < RB; ++k) {
            const int m = m0 + k * NGW; const bool ok = m < TG; const size_t mm = ok ? m : m0;
            if (HIN_F32) { const f32x4* xr = (const f32x4*)((const float*)hin_ + mm * DM) + lane;
#pragma unroll
                for (int j = 0; j < 4; ++j) v[k][j] = xr[64 * j]; }
            else { const u32x2* xr = (const u32x2*)((const bf16_t*)hin_ + mm * DM) + lane;
#pragma unroll
                for (int j = 0; j < 4; ++j) { const u32x2 w = xr[64 * j]; v[k][j] = (f32x4){bflo(w.x), bfhi(w.x), bflo(w.y), bfhi(w.y)}; } }
            if (F) { const u32x2* fr_ = (const u32x2*)(F + mm * DM) + lane;
#pragma unroll
                for (int j = 0; j < 4; ++j) fw[k][j] = fr_[64 * j]; }
        }
        f32x4 gp[4], gn[4];
        if (F) {
#pragma unroll
            for (int j = 0; j < 4; ++j) gp[j] = *((const f32x4*)gpost + lane + 64 * j);
        }
        if (U) {
#pragma unroll
            for (int j = 0; j < 4; ++j) gn[j] = *((const f32x4*)gnext + lane + 64 * j);
        }
#pragma unroll
        for (int k = 0; k < RB; ++k) {
            const int m = m0 + k * NGW; if (m >= TG) continue;
            if (F) {
                f32x4 f[4]; float ss = 0.f;
#pragma unroll
                for (int j = 0; j < 4; ++j) { const u32x2 w = fw[k][j]; f[j] = (f32x4){bflo(w.x), bfhi(w.x), bflo(w.y), bfhi(w.y)}; ss += (f[j].x * f[j].x + f[j].y * f[j].y) + (f[j].z * f[j].z + f[j].w * f[j].w); }
                const float rs = __builtin_amdgcn_rsqf(wave_sum(ss, lane) * (1.f / DM) + EPS);
#pragma unroll
                for (int j = 0; j < 4; ++j) v[k][j] = v[k][j] + f[j] * rs * gp[j];
            }
            if (HOUT_F32) { f32x4* orow = (f32x4*)((float*)hout_ + (size_t)m * DM) + lane;
#pragma unroll
                for (int j = 0; j < 4; ++j) orow[64 * j] = v[k][j]; }
            else { u32x2* o8 = (u32x2*)((bf16_t*)hout_ + (size_t)m * DM) + lane;
#pragma unroll
                for (int j = 0; j < 4; ++j) o8[64 * j] = (u32x2){cvtpk(v[k][j].x, v[k][j].y), cvtpk(v[k][j].z, v[k][j].w)}; }
            if (U) {
                float ss = 0.f;
#pragma unroll
                for (int j = 0; j < 4; ++j) ss += (v[k][j].x * v[k][j].x + v[k][j].y * v[k][j].y) + (v[k][j].z * v[k][j].z + v[k][j].w * v[k][j].w);
                const float rs = __builtin_amdgcn_rsqf(wave_sum(ss, lane) * (1.f / DM) + EPS);
                u32x2* o8 = (u32x2*)(U + (size_t)m * DM) + lane;
#pragma unroll
                for (int j = 0; j < 4; ++j) { const f32x4 y = v[k][j] * rs * gn[j]; o8[64 * j] = (u32x2){cvtpk(y.x, y.y), cvtpk(y.z, y.w)}; }
            }
        }
    }
}
DI void ple_phase(const float* ple, bf16_t* PB, int gw, int NGW) {
    int tid_ = threadIdx.x; asm volatile("" : "+v"(tid_)); const int lane = tid_ & 63;
    for (int m0 = gw; m0 < TG; m0 += 8 * NGW) {
        f32x4 v[8];
#pragma unroll
        for (int k = 0; k < 8; ++k) { const int m = m0 + k * NGW; const size_t mm = m < TG ? m : m0; v[k] = *((const f32x4*)(ple + mm * PLED) + lane); }
#pragma unroll
        for (int k = 0; k < 8; ++k) { const int m = m0 + k * NGW; if (m < TG) *((u32x2*)(PB + (size_t)m * PLED) + lane) = (u32x2){cvtpk(v[k].x, v[k].y), cvtpk(v[k].z, v[k].w)}; }
    }
}
DI void rope_phase(bf16_t* Z, const float* gq, const float* gk, int S, int gw, int NGW, unsigned* kmax_word, unsigned* kcmax_word) {
    int tid_ = threadIdx.x; asm volatile("" : "+v"(tid_)); const int lane = tid_ & 63;
    const float freq = fexp2(-(float)(lane & 31) * 0.41524101186092029f);
    constexpr float QSC128 = 0.08838834764831845f * LOG2E;
    const float gq0 = gq[2 * lane] * QSC128, gq1 = gq[2 * lane + 1] * QSC128, gk0 = gk[2 * lane], gk1 = gk[2 * lane + 1];
    float kcmax2 = 0.f;
    float kmax2 = 0.f;
    for (int t0 = gw; t0 < TG; t0 += 2 * NGW) {
        unsigned w[2][10]; u32x4 ka[2][2];
#pragma unroll
        for (int k = 0; k < 2; ++k) { const int t = t0 + k * NGW; const size_t tt = t < TG ? t : t0;
            const u32x4* kp_ = (const u32x4*)(Z + tt * ZW + Z_KA) + 2 * lane; ka[k][0] = kp_[0]; ka[k][1] = kp_[1]; }
#pragma unroll
        for (int k = 0; k < 2; ++k) { const int t = t0 + k * NGW; const size_t tt = t < TG ? t : t0;
            const unsigned* base = (const unsigned*)(Z + tt * ZW + Z_QC) + lane;
#pragma unroll
            for (int hh = 0; hh < 10; ++hh) w[k][hh] = base[64 * hh]; }
#pragma unroll
        for (int k = 0; k < 2; ++k) {
            const int t = t0 + k * NGW; if (t >= TG) continue;
            { float ss = 0.f;
#pragma unroll
              for (int e = 0; e < 2; ++e) { const u32x4 x = ka[k][e]; const float a0 = bflo(x.x), a1 = bfhi(x.x), a2 = bflo(x.y), a3 = bfhi(x.y), a4 = bflo(x.z), a5 = bfhi(x.z), a6 = bflo(x.w), a7 = bfhi(x.w);
                  ss += (a0 * a0 + a1 * a1) + (a2 * a2 + a3 * a3) + (a4 * a4 + a5 * a5) + (a6 * a6 + a7 * a7); }
              ss += __builtin_bit_cast(float, __builtin_amdgcn_ds_bpermute((lane ^ 1) << 2, __builtin_bit_cast(int, ss)));
              ss += __builtin_bit_cast(float, __builtin_amdgcn_ds_bpermute((lane ^ 2) << 2, __builtin_bit_cast(int, ss)));
              kmax2 = fmaxf(kmax2, ss); }
            unsigned* base = (unsigned*)(Z + (size_t)t * ZW + Z_QC) + lane;
            const int s = t % S, prow = s >> 6, pcol = s & 63;
            const float ang = (float)(lane < 32 ? prow : pcol) * freq, rev = ang * 0.15915494309189535f;
            const float sn = __builtin_amdgcn_sinf(rev), cs = __builtin_amdgcn_cosf(rev);
#pragma unroll
            for (int hh = 0; hh < 10; ++hh) {
                const float x0 = bflo(w[k][hh]), x1 = bfhi(w[k][hh]);
                const float rs = __builtin_amdgcn_rsqf(wave_sum(x0 * x0 + x1 * x1, lane) * (1.f / 128.f) + EPS);
                const float y0 = x0 * rs * (hh < 8 ? gq0 : gk0), y1 = x1 * rs * (hh < 8 ? gq1 : gk1);
                if (hh >= 8) kcmax2 = fmaxf(kcmax2, wave_sum(y0 * y0 + y1 * y1, lane));
                base[64 * hh] = cvtpk(y0 * cs - y1 * sn, y0 * sn + y1 * cs);
            }
        }
    }
#pragma unroll
    for (int o = 4; o < 32; o <<= 1) kmax2 = fmaxf(kmax2, __builtin_bit_cast(float, __builtin_amdgcn_ds_bpermute((lane ^ o) << 2, __builtin_bit_cast(int, kmax2))));
    kmax2 = xor32_max(kmax2);
    if (lane == 0) (void)__hip_atomic_fetch_max(kmax_word, __builtin_bit_cast(unsigned, kmax2), __ATOMIC_RELAXED, __HIP_MEMORY_SCOPE_AGENT);
    if (lane == 0) (void)__hip_atomic_fetch_max(kcmax_word, __builtin_bit_cast(unsigned, kcmax2), __ATOMIC_RELAXED, __HIP_MEMORY_SCOPE_AGENT);
}

#define MFMA32(a, b, c) __builtin_amdgcn_mfma_f32_32x32x16_bf16((a), (b), (c), 0, 0, 0)
constexpr int AT_KS = 0, AT_VS = 33792, AT_RPB = 33792 + 36864;
constexpr int VSTR_B = 136;

template <int ROWS, int ROWLEN, int N>
DI void tile_gload(u32x4 (&v)[N], const bf16_t* src, unsigned ld, int tid) {
    static_assert(N * 512 * 8 == ROWS * ROWLEN, "tile");
    constexpr int CPR = ROWLEN / 8;
#pragma unroll
    for (int i = 0; i < N; ++i) { const unsigned c = (unsigned)tid + 512u * i, row = c / CPR, ch = c % CPR; const unsigned off = (row * ld + ch * 8u) * 2u; v[i] = *(const u32x4*)((const char*)src + off); }
}
template <int ROWS, int ROWLEN, int N>
DI void tile_sstore(const u32x4 (&v)[N], LAS unsigned char* dst, int tid) {
    constexpr int CPR = ROWLEN / 8, STR = (ROWLEN == 64) ? 136 : (ROWLEN + 8) * 2;
#pragma unroll
    for (int i = 0; i < N; ++i) { const int c = tid + 512 * i, row = c / CPR, ch = c % CPR;
        if (ROWLEN == 64) { *(LAS u32x2*)(dst + row * STR + ch * 16) = (u32x2){v[i].x, v[i].y}; *(LAS u32x2*)(dst + row * STR + ch * 16 + 8) = (u32x2){v[i].z, v[i].w}; }
        else *(LAS u32x4*)(dst + row * STR + ch * 16) = v[i]; }
}
template <int NDS>
DI f32x16 qk_block(const LAS unsigned char* kp, const bf16x8* qf, f32x16 s = (f32x16){}) {
#pragma unroll
    for (int ds = 0; ds < NDS; ++ds) { const bf16x8 a = *(const LAS bf16x8*)(kp + ds * 32); s = MFMA32(a, qf[ds], s); }
    return s;
}
DI bf16x8 pack8(const f32x16& p, int s2) {
    u32x4 w;
    if (s2 == 0) { w.x = cvtpk(p[0], p[1]); w.y = cvtpk(p[2], p[3]); w.z = cvtpk(p[4], p[5]); w.w = cvtpk(p[6], p[7]); }
    else { w.x = cvtpk(p[8], p[9]); w.y = cvtpk(p[10], p[11]); w.z = cvtpk(p[12], p[13]); w.w = cvtpk(p[14], p[15]); }
    return __builtin_bit_cast(bf16x8, w);
}
template <int NDB>
DI void pv_block(f32x16* o, const LAS unsigned char* vp, bf16x8 pf0, bf16x8 pf1) {
#pragma unroll
    for (int db = 0; db < NDB; ++db) {
        const LAS unsigned char* p = vp + db * 32 * VSTR_B;
        const s16x4 lo0 = *(const LAS s16x4*)(p), hi0 = *(const LAS s16x4*)(p + 16), lo1 = *(const LAS s16x4*)(p + 32), hi1 = *(const LAS s16x4*)(p + 48);
        const bf16x8 v0 = __builtin_shufflevector(lo0, hi0, 0, 1, 2, 3, 4, 5, 6, 7), v1 = __builtin_shufflevector(lo1, hi1, 0, 1, 2, 3, 4, 5, 6, 7);
        o[db] = MFMA32(v0, pf0, o[db]); o[db] = MFMA32(v1, pf1, o[db]);
    }
}
DI float max16(const f32x16& s) {
    float a = fmaxf(fmaxf(s[0], s[1]), fmaxf(s[2], s[3])), b = fmaxf(fmaxf(s[4], s[5]), fmaxf(s[6], s[7]));
    float c = fmaxf(fmaxf(s[8], s[9]), fmaxf(s[10], s[11])), d = fmaxf(fmaxf(s[12], s[13]), fmaxf(s[14], s[15]));
    return fmaxf(fmaxf(a, b), fmaxf(c, d));
}
template <int NDB, bool MASKED>
DI void softmax_pv(f32x16& s, float c, float& m, float& l, f32x16* o, const LAS unsigned char* vp) {
    float mx = max16(s) * c; mx = xor32_max(mx);
    const float mn = fmaxf(m, mx);
    const float ms = (MASKED && mn == -INFINITY) ? 0.f : mn;
    const float alpha = fexp2(m - ms);
    float ls = 0.f;
#pragma unroll
    for (int i = 0; i < 16; ++i) { s[i] = fexp2(__builtin_fmaf(s[i], c, -ms)); ls += s[i]; }
    l = l * alpha + ls; m = mn;
    if (__any(alpha != 1.0f)) {
#pragma unroll
        for (int db = 0; db < NDB; ++db) o[db] *= alpha;
    }
    pv_block<NDB>(o, vp, pack8(s, 0), pack8(s, 1));
}
DI void stats_step(const f32x16& s, float& m, float& l) {
    float mx = max16(s); mx = xor32_max(mx);
    const float mn = fmaxf(m, mx);
    float ls = 0.f;
#pragma unroll
    for (int i = 0; i < 16; ++i) ls += fexp2(s[i] - mn);
    l = l * fexp2(m - mn) + ls; m = mn;
}
template <int NDB, bool GAIN>
DI void store_o(const f32x16* o, bf16_t* dst  , float sc, const float* gain, int h) {
#pragma unroll
    for (int db = 0; db < NDB; ++db)
#pragma unroll
        for (int k = 0; k < 4; k += 2) {
            unsigned pa[2], pb[2];
#pragma unroll
            for (int gi = 0; gi < 2; ++gi) {
                const int g = k + gi, d = 32 * db + 8 * g + 4 * h;
                float a = o[db][4 * g] * sc, b = o[db][4 * g + 1] * sc, c = o[db][4 * g + 2] * sc, e = o[db][4 * g + 3] * sc;
                if (GAIN) { const f32x4 gg = *(const f32x4*)(gain + d); a *= gg.x; b *= gg.y; c *= gg.z; e *= gg.w; }
                if (gi == 0) { pa[0] = cvtpk(a, b); pa[1] = cvtpk(c, e); } else { pb[0] = cvtpk(a, b); pb[1] = cvtpk(c, e); }
            }
            swap32(pa[0], pb[0]); swap32(pa[1], pb[1]);
            *(u32x4*)(dst + 32 * db + 8 * (k + h)) = (u32x4){pa[0], pa[1], pb[0], pb[1]};
        }
}

constexpr int DA_KS = 0, DA_VS = 17408, DA_STG = 34816, DA_XO = 36864, DA_XS = 106496;
template <bool st> DI void da_unit(int layer, int b, int hd, int qb, int S, bf16_t* Z, const bf16_t* VT, const float* da_lambda, const float* da_norm, LAS unsigned char* lds, const unsigned* kmax_word) {
    int tid_ = threadIdx.x; asm volatile("" : "+v"(tid_));
    const int tid = tid_, lane = tid & 63, r = lane & 31, h = lane >> 5, wid = __builtin_amdgcn_readfirstlane(tid >> 6);
    const int mp = wid >> 2, wr = wid & 3;
    const int tb = b * S, q0 = qb * 128 + wr * 32, qpos = q0 + r, NT = S / 64;
    bf16_t* qrow = Z + (size_t)(tb + q0 + r) * ZW + Z_QA + hd * 128;
    const float sl = fexp2(-(float)(hd + 1)) * LOG2E;
    bf16x8 qf[4];
    float qn2 = 0.f;
#pragma unroll
    for (int ds = 0; ds < 4; ++ds) { qf[ds] = *(const bf16x8*)(qrow + mp * 64 + 16 * ds + 8 * h);
#pragma unroll
        for (int j = 0; j < 8; ++j) { const float x = bf2f((unsigned short)qf[ds][j]); qn2 += x * x; } }
    qn2 = xor32_sum(qn2);
    float qm = qn2;
#pragma unroll
    for (int o_ = 1; o_ < 32; o_ <<= 1) qm = fmaxf(qm, __builtin_bit_cast(float, __builtin_amdgcn_ds_bpermute((lane ^ o_) << 2, __builtin_bit_cast(int, qm))));
    LAS float* xs = (LAS float*)(lds + DA_XS);
    __syncthreads();
    if (lane == 0) xs[wid] = qm;
    __syncthreads();
    float qb2 = xs[0];
#pragma unroll
    for (int w = 1; w < 8; ++w) qb2 = fmaxf(qb2, xs[w]);
    const float kmax2 = __builtin_bit_cast(float, __hip_atomic_load(kmax_word, __ATOMIC_RELAXED, __HIP_MEMORY_SCOPE_AGENT));
    const float sbnd = __builtin_sqrtf(qb2 * kmax2) * 1.01f;
    const float D = (2.f * sbnd + 150.f) / sl, Q0 = (float)(qb * 128);
    const float lo = __builtin_ceilf((Q0 - 63.f - D) * (1.f / 64.f)), hi = __builtin_floorf((Q0 + 127.f + D) * (1.f / 64.f));
    int t_lo = lo < 0.f ? 0 : (int)lo, t_hi = hi > (float)(NT - 1) ? NT - 1 : (int)hi;
    t_lo = __builtin_amdgcn_readfirstlane(t_lo); t_hi = __builtin_amdgcn_readfirstlane(t_hi);
    const float sq = __builtin_sqrtf(qn2 * kmax2) * 1.01f;
    const float mref = fminf(sq, 100.f - sq);
    const bool fast = sbnd <= 110.f;
    const bf16_t* kt = Z + (size_t)tb * ZW + Z_KA + hd * 128;
    const bf16_t* vt = VT + (size_t)(V_A + hd * 128) * TG + tb;
    LAS unsigned char* KS = lds + DA_KS; LAS unsigned char* VS = lds + DA_VS;
    const LAS unsigned char* kp = KS + r * 272 + (mp * 64 + 8 * h) * 2;
    const LAS unsigned char* vp = VS + r * VSTR_B + 8 * h;
    const float slc = -sl;
    float l = 0.f;
    f32x16 o[4];
#pragma unroll
    for (int db = 0; db < 4; ++db) o[db] = (f32x16){};
    u32x4 kr[2], vr[2];
    tile_gload<64, 128>(kr, kt + (size_t)t_lo * 64 * ZW, ZW, tid); tile_gload<128, 64>(vr, vt + (size_t)t_lo * 64, TG, tid);
    if (fast) {
        const float mrc = -mref;
        tile_sstore<64, 128>(kr, KS, tid); tile_sstore<128, 64>(vr, VS, tid);
        if (t_lo + 1 <= t_hi) { tile_gload<64, 128>(kr, kt + (size_t)(t_lo + 1) * 64 * ZW, ZW, tid); tile_gload<128, 64>(vr, vt + (size_t)(t_lo + 1) * 64, TG, tid); }
        __syncthreads();
        for (int t = t_lo; t <= t_hi; ++t) {
            const int cur = ((t - t_lo) & 1) * DA_STG, nxt = DA_STG - cur;
            if (t + 1 <= t_hi) { tile_sstore<64, 128>(kr, KS + nxt, tid); tile_sstore<128, 64>(vr, VS + nxt, tid); }
            if (t + 2 <= t_hi) { tile_gload<64, 128>(kr, kt + (size_t)(t + 2) * 64 * ZW, ZW, tid); tile_gload<128, 64>(vr, vt + (size_t)(t + 2) * 64, TG, tid); }
            const float base = (float)(qpos - (t * 64 + 4 * h));
            f32x16 ta, tb_;
            const int side = (t * 64 + 63 < q0) ? 1 : ((t * 64 > q0 + 31) ? -1 : 0);
            if (side != 0) {
                const float ssl = (side > 0) ? slc : -slc;
                const float a0 = __builtin_fmaf(base, ssl, mrc), a1 = __builtin_fmaf(base - 32.f, ssl, mrc);
#pragma unroll
                for (int i = 0; i < 16; ++i) { const float ci = (float)((i & 3) + 8 * (i >> 2)); float x0 = __builtin_fmaf(-ssl, ci, a0), x1 = __builtin_fmaf(-ssl, ci, a1); asm volatile("" : "+v"(x0), "+v"(x1));   ta[i] = x0; tb_[i] = x1; }
            } else {
#pragma unroll
                for (int i = 0; i < 16; ++i) { const float ci = (float)((i & 3) + 8 * (i >> 2)); float x0 = __builtin_fmaf(fabsf(base - ci), slc, mrc), x1 = __builtin_fmaf(fabsf(base - 32.f - ci), slc, mrc); asm volatile("" : "+v"(x0), "+v"(x1)); ta[i] = x0; tb_[i] = x1; }
            }
            f32x16 sa = qk_block<4>(kp + cur, qf, ta);
            f32x16 sb_ = qk_block<4>(kp + cur + 32 * 272, qf, tb_);
            float ls = 0.f;
#pragma unroll
            for (int i = 0; i < 16; ++i) { sa[i] = fexp2(sa[i]); ls += sa[i]; }
            pv_block<4>(o, vp + cur, pack8(sa, 0), pack8(sa, 1));
#pragma unroll
            for (int i = 0; i < 16; ++i) { sb_[i] = fexp2(sb_[i]); ls += sb_[i]; }
            l += ls;
            pv_block<4>(o, vp + cur + 64, pack8(sb_, 0), pack8(sb_, 1));
            __syncthreads();
        }
    } else {
        float m = -INFINITY;
        for (int t = t_lo; t <= t_hi; ++t) {
            __syncthreads(); tile_sstore<64, 128>(kr, KS, tid); tile_sstore<128, 64>(vr, VS, tid); __syncthreads();
            if (t + 1 <= t_hi) { tile_gload<64, 128>(kr, kt + (size_t)(t + 1) * 64 * ZW, ZW, tid); tile_gload<128, 64>(vr, vt + (size_t)(t + 1) * 64, TG, tid); }
#pragma unroll 1
            for (int kb = 0; kb < 2; ++kb) {
                const float base = (float)(qpos - (t * 64 + 32 * kb + 4 * h));
                f32x16 ta;
#pragma unroll
                for (int i = 0; i < 16; ++i) ta[i] = fabsf(base - (float)((i & 3) + 8 * (i >> 2))) * slc;
                f32x16 s = qk_block<4>(kp + kb * 32 * 272, qf, ta);
                softmax_pv<4, false>(s, 1.0f, m, l, o, vp + kb * 64);
            }
        }
    }
    l = xor32_sum(l);
    const float* L = da_lambda + layer * 256;
    const float sa_ = wave_sum(L[lane] * L[64 + lane], lane), sb2 = wave_sum(L[128 + lane] * L[192 + lane], lane);
    const float linit = 0.8f - 0.6f * __expf(-0.3f * (float)layer);
    const float lam = __expf(sa_) - __expf(sb2) + linit;
    LAS unsigned char* xo = lds + DA_XO + wr * 17408 + lane * 272;
    __syncthreads();
    if (mp == 1) { const float sc1 = lam / l;
#pragma unroll
        for (int db = 0; db < 4; ++db)
#pragma unroll
            for (int k = 0; k < 4; ++k) *(LAS f32x4*)(xo + (db * 16 + 4 * k) * 4) = (f32x4){o[db][4 * k] * sc1, o[db][4 * k + 1] * sc1, o[db][4 * k + 2] * sc1, o[db][4 * k + 3] * sc1}; }
    __syncthreads();
    if (mp == 0) {
        const float il = 1.0f / l; float ss = 0.f;
#pragma unroll
        for (int db = 0; db < 4; ++db)
#pragma unroll
            for (int k = 0; k < 4; ++k) { const f32x4 x = *(const LAS f32x4*)(xo + (db * 16 + 4 * k) * 4);
#pragma unroll
                for (int j = 0; j < 4; ++j) { const float v = o[db][4 * k + j] * il - x[j]; o[db][4 * k + j] = v; ss += v * v; } }
        ss = xor32_sum(ss);
        const float rn = __builtin_amdgcn_rsqf(ss * (1.f / 128.f) + EPS) * (1.0f - linit);
        if (st) store_o<4, true>(o, qrow, rn, da_norm + layer * 128, h);
    }
}

template <bool st> DI void gqa_unit(int b, int hq, int qb, int S, bf16_t* Z, const bf16_t* VT, LAS unsigned char* lds, const unsigned* kcmax_word) {
    int tid_ = threadIdx.x; asm volatile("" : "+v"(tid_));
    const int tid = tid_, lane = tid & 63, r = lane & 31, h = lane >> 5, wid = __builtin_amdgcn_readfirstlane(tid >> 6);
    const int tb = b * S, q0 = qb * 256 + wid * 32, NT = S / 64, kvh = hq >> 2;
    bf16_t* qrow = Z + (size_t)(tb + q0 + r) * ZW + Z_QC + hq * 128;
    bf16x8 qf[8];
    float qn2 = 0.f;
#pragma unroll
    for (int ds = 0; ds < 8; ++ds) { qf[ds] = *(const bf16x8*)(qrow + 16 * ds + 8 * h);
#pragma unroll
        for (int j = 0; j < 8; ++j) { const float x = bf2f((unsigned short)qf[ds][j]); qn2 += x * x; } }
    qn2 = xor32_sum(qn2);
    const bf16_t* kt = Z + (size_t)tb * ZW + Z_KC + kvh * 128;
    const bf16_t* vt = VT + (size_t)(V_C + kvh * 128) * TG + tb;
    LAS unsigned char* KS = lds + AT_KS; LAS unsigned char* VS = lds + AT_VS;
    const LAS unsigned char* kp = KS + r * 272 + 16 * h;
    const LAS unsigned char* vp = VS + r * VSTR_B + 8 * h;
    const float kc2 = __builtin_bit_cast(float, __hip_atomic_load(kcmax_word, __ATOMIC_RELAXED, __HIP_MEMORY_SCOPE_AGENT));
    const float sq = __builtin_sqrtf(qn2 * kc2) * 1.01f;
    const float mref = fminf(sq, 100.f - sq);
    const bool fixed_ref = !__any(sq > 110.f);
    __syncthreads();
    LAS int* fx = (LAS int*)(lds + AT_RPB);
    if (tid == 0) *fx = 0;
    __syncthreads();
    if (!fixed_ref && lane == 0) *fx = 1;
    __syncthreads();
    const bool fast = __builtin_amdgcn_readfirstlane(*(volatile LAS int*)fx) == 0;
    float l = 0.f;
    f32x16 o[4];
#pragma unroll
    for (int db = 0; db < 4; ++db) o[db] = (f32x16){};
    u32x4 kr[2], vr[2];
    tile_gload<64, 128>(kr, kt, ZW, tid); tile_gload<128, 64>(vr, vt, TG, tid);
    if (fast) {
        const float mrc = -mref;
        f32x16 cinit;
#pragma unroll
        for (int i = 0; i < 16; ++i) cinit[i] = mrc;
        for (int t = 0; t < NT; ++t) {
            __syncthreads(); tile_sstore<64, 128>(kr, KS, tid); tile_sstore<128, 64>(vr, VS, tid); __syncthreads();
            if (t + 1 < NT) { tile_gload<64, 128>(kr, kt + (size_t)(t + 1) * 64 * ZW, ZW, tid); tile_gload<128, 64>(vr, vt + (size_t)(t + 1) * 64, TG, tid); }
            f32x16 sa = qk_block<8>(kp, qf, cinit);
            f32x16 sb_ = qk_block<8>(kp + 32 * 272, qf, cinit);
            float ls = 0.f;
#pragma unroll
            for (int i = 0; i < 16; ++i) { sa[i] = fexp2(sa[i]); ls += sa[i]; }
            pv_block<4>(o, vp, pack8(sa, 0), pack8(sa, 1));
#pragma unroll
            for (int i = 0; i < 16; ++i) { sb_[i] = fexp2(sb_[i]); ls += sb_[i]; }
            l += ls;
            pv_block<4>(o, vp + 64, pack8(sb_, 0), pack8(sb_, 1));
        }
    } else {
        float m = -INFINITY;
        for (int t = 0; t < NT; ++t) {
            __syncthreads(); tile_sstore<64, 128>(kr, KS, tid); tile_sstore<128, 64>(vr, VS, tid); __syncthreads();
            if (t + 1 < NT) { tile_gload<64, 128>(kr, kt + (size_t)(t + 1) * 64 * ZW, ZW, tid); tile_gload<128, 64>(vr, vt + (size_t)(t + 1) * 64, TG, tid); }
#pragma unroll
            for (int kb = 0; kb < 2; ++kb) {
                f32x16 s = qk_block<8>(kp + kb * 32 * 272, qf);
                softmax_pv<4, false>(s, 1.0f, m, l, o, vp + kb * 64);
            }
        }
    }
    l = xor32_sum(l);
    if (st) store_o<4, false>(o, qrow, 1.0f / l, nullptr, h);
}

template <bool st> DI void na_unit(int layer, int b, int rp_, int hp, int S, bf16_t* Z, const bf16_t* VT, const float* na_rpb, LAS unsigned char* lds) {
    int tid_ = threadIdx.x; asm volatile("" : "+v"(tid_));
    const int tid = tid_, lane = tid & 63, r = lane & 31, h = lane >> 5, wid = __builtin_amdgcn_readfirstlane(tid >> 6);
    const int hl = wid >> 2, rs = (wid >> 1) & 1, half = wid & 1, head = hp * 2 + hl, rows = S / 64, row = 2 * rp_ + rs;
    const int tb = b * S;
    int start = row - 4; start = start < 0 ? 0 : start; start = start > rows - 8 ? rows - 8 : start;
    int j_lo = 2 * rp_ - 4; j_lo = j_lo < 0 ? 0 : j_lo; j_lo = j_lo > rows - 8 ? rows - 8 : j_lo;
    int j_hi = 2 * rp_ + 1 - 4; j_hi = j_hi < 0 ? 0 : j_hi; j_hi = j_hi > rows - 8 ? rows - 8 : j_hi; j_hi += 7;
    LAS unsigned char* KS = lds + AT_KS; LAS unsigned char* VS = lds + AT_VS; LAS float* RP = (LAS float*)(lds + AT_RPB);
    __syncthreads();
    { const float* src = na_rpb + ((size_t)layer * 16 + hp * 2) * 465;
      for (int i = tid; i < 2 * 465; i += 512) RP[i] = src[i] * LOG2E; }
    bf16_t* qrow = Z + (size_t)(tb + row * 64 + half * 32 + r) * ZW + Z_QN + head * 64;
    bf16x8 qf[4];
#pragma unroll
    for (int ds = 0; ds < 4; ++ds) qf[ds] = *(const bf16x8*)(qrow + 16 * ds + 8 * h);
    const bf16_t* kt = Z + (size_t)tb * ZW + Z_KN + hp * 128;
    const bf16_t* vt = VT + (size_t)(V_N + hp * 128) * TG + tb;
    const LAS unsigned char* kp = KS + r * 272 + (hl * 64 + 8 * h) * 2;
    const LAS unsigned char* vp = VS + (hl * 64 + r) * VSTR_B + 8 * h;
    const int cq = 32 * half + r; int cs = cq - 8; cs = cs < 0 ? 0 : cs; cs = cs > 48 ? 48 : cs;
    float m = -INFINITY, l = 0.f;
    f32x16 o[2]; o[0] = (f32x16){}; o[1] = (f32x16){};
    f32x16 mneg[2]; int boff[2][16];
#pragma unroll
    for (int kb = 0; kb < 2; ++kb)
#pragma unroll
        for (int i = 0; i < 16; ++i) {
            const int ck = 32 * kb + (i & 3) + 8 * (i >> 2) + 4 * h;
            int idx = ck - cq + 15; idx = idx < 0 ? 0 : idx; idx = idx > 30 ? 30 : idx;
            boff[kb][i] = idx * 4;
            mneg[kb][i] = ((ck >= cs) && (ck < cs + 16)) ? 0.f : -INFINITY;
        }
    u32x4 kr[2], vr[2];
    tile_gload<64, 128>(kr, kt + (size_t)j_lo * 64 * ZW, ZW, tid); tile_gload<128, 64>(vr, vt + (size_t)j_lo * 64, TG, tid);
    for (int j = j_lo; j <= j_hi; ++j) {
        __syncthreads(); tile_sstore<64, 128>(kr, KS, tid); tile_sstore<128, 64>(vr, VS, tid); __syncthreads();
        if (j + 1 <= j_hi) { tile_gload<64, 128>(kr, kt + (size_t)(j + 1) * 64 * ZW, ZW, tid); tile_gload<128, 64>(vr, vt + (size_t)(j + 1) * 64, TG, tid); }
        if (j < start || j >= start + 8) continue;
        const int dr = j - row + 7;
        const LAS unsigned char* rpb = (const LAS unsigned char*)(RP + hl * 465 + dr * 31);
#pragma unroll
        for (int kb = 0; kb < 2; ++kb) {
            f32x16 s = qk_block<4>(kp + kb * 32 * 272, qf, mneg[kb]);
#pragma unroll
            for (int i = 0; i < 16; ++i) s[i] += *(const LAS float*)(rpb + boff[kb][i]);
            softmax_pv<2, true>(s, 1.0f, m, l, o, vp + kb * 64);
        }
    }
    l = xor32_sum(l);
    if (st) store_o<2, false>(o, qrow, 1.0f / l, nullptr, h);
}


#define GAS __attribute__((address_space(1)))
#define XB_TMO      128
#define XB_XCNT(j)  (256  + 64 * (j))
#define XB_XSUB(j)  (1280 + 64 * (j))
#define XB_XGEN(j)  (2304 + 64 * (j))
#define XB_TOP      3328
#define XB_TOPGEN   3392
#define XCD_BAR_WORDS 3456
#define XB_SPIN_CAP (1u << 18)

__device__ __forceinline__ unsigned xb_ld(unsigned* p)              { return __hip_atomic_load(p, __ATOMIC_RELAXED, __HIP_MEMORY_SCOPE_AGENT); }
__device__ __forceinline__ unsigned xb_add(unsigned* p, unsigned v) { return __hip_atomic_fetch_add(p, v, __ATOMIC_RELAXED, __HIP_MEMORY_SCOPE_AGENT); }
__device__ __forceinline__ unsigned xb_xcc_id() { return (unsigned)__builtin_amdgcn_s_getreg((3 << 11) | 20) & 0xFu; }
#define XB_SPIN(cond, bar) do { unsigned _sp = 0; while (cond) { __builtin_amdgcn_s_sleep(1); \
    if ((++_sp & 255u) == 0u) { if (xb_ld(&(bar)[XB_TMO])) break; if (_sp > XB_SPIN_CAP) { atomicAdd(&(bar)[XB_TMO], 1u); break; } } } } while (0)

struct XcdBarrier {
    unsigned* bar; unsigned x;
    volatile LAS unsigned* st;
};

__device__ __forceinline__ XcdBarrier xcd_barrier_post(unsigned* bar, volatile LAS unsigned* st) {
    XcdBarrier b; b.bar = bar; b.x = xb_xcc_id(); b.st = st;
    if (threadIdx.x == 0) (void)xb_add(&bar[XB_XCNT(b.x)], 1u);
    return b;
}
__device__ __forceinline__ void xcd_barrier_complete(unsigned* bar, unsigned x, unsigned& nloc, unsigned& nx) {
    const unsigned G = gridDim.x * gridDim.y * gridDim.z;
    unsigned sum, cnt, mine, sp = 0u;
    for (;;) {
        sum = 0u; cnt = 0u; mine = 0u;
#pragma unroll
        for (unsigned j = 0; j < 16; ++j) { const unsigned c = xb_ld(&bar[XB_XCNT(j)]); sum += c; cnt += (c > 0u) ? 1u : 0u; mine = (j == x) ? c : mine; }
        if (sum == G) break;
        __builtin_amdgcn_s_sleep(1);
        if ((++sp & 255u) == 0u) { if (xb_ld(&bar[XB_TMO])) break; if (sp > XB_SPIN_CAP) { atomicAdd(&bar[XB_TMO], 1u); break; } }
    }
    nloc = mine > 0u ? mine : 1u; nx = cnt > 0u ? cnt : 1u;
}

__device__ __forceinline__ void xcd_barrier(const XcdBarrier& b) {
    asm volatile("s_waitcnt vmcnt(0)" ::: "memory");
    __syncthreads();
    if (threadIdx.x == 0) {
        unsigned* bar = b.bar;
        __builtin_amdgcn_s_waitcnt(0);
        unsigned nloc = b.st[0], nx = b.st[1];
        if (nloc == 0u) { xcd_barrier_complete(bar, b.x, nloc, nx); b.st[0] = nloc; b.st[1] = nx; }
        const unsigned old = xb_add(&bar[XB_XSUB(b.x)], 1u);
        const unsigned gen = old / nloc;
        if (old + 1u == (gen + 1u) * nloc) {
            __builtin_amdgcn_fence(__ATOMIC_RELEASE, "agent");
            asm volatile("s_waitcnt vmcnt(0)" ::: "memory");
            const unsigned og = xb_add(&bar[XB_TOP], 1u);
            const unsigned tg = og / nx;
            if (og + 1u == (tg + 1u) * nx) xb_add(&bar[XB_TOPGEN], 1u);
            else XB_SPIN(xb_ld(&bar[XB_TOPGEN]) == tg, bar);
            __builtin_amdgcn_fence(__ATOMIC_ACQUIRE, "agent");
            xb_add(&bar[XB_XGEN(b.x)], 1u);
            asm volatile("s_waitcnt vmcnt(0)" ::: "memory");
        } else {
            XB_SPIN(xb_ld(&bar[XB_XGEN(b.x)]) == gen, bar);
            __builtin_amdgcn_fence(__ATOMIC_ACQUIRE, "agent");
            asm volatile("s_waitcnt vmcnt(0)" ::: "memory");
        }
    }
    __syncthreads();
}


constexpr int QX_W = 3700;
constexpr int QCTR_W = 3616;
constexpr int KCMAX_W = 3632;
constexpr int KMAX_W = 3600;
constexpr int PTAB_OFF = 134144, BARST_OFF = PTAB_OFF + 256, QSLOT_OFF = PTAB_OFF + 272;
DI const float* ld_ptr(LAS unsigned char* lds, int k) {
    int off = PTAB_OFF + 8 * k; asm volatile("" : "+v"(off));
    const unsigned long long v = *(volatile LAS unsigned long long*)(lds + off);
    const unsigned lo = __builtin_amdgcn_readfirstlane((unsigned)v), hi = __builtin_amdgcn_readfirstlane((unsigned)(v >> 32));
    return (const float*)(GAS const float*)(((unsigned long long)hi << 32) | lo);
}
struct Args { const float* in[23]; float* out; unsigned char* ws; };

__global__ void __launch_bounds__(512, 2) fwd_megakernel(Args args) {
    extern __shared__ __attribute__((aligned(16))) unsigned char lds_raw[];
    LAS unsigned char* lds = (LAS unsigned char*)lds_raw;
    cg::grid_group grid = cg::this_grid();
#define GSYNC() do { xcd_barrier(xbar); if (REP_SYNC > 1) xcd_barrier(xbar); } while (0)
    const int wave = __builtin_amdgcn_readfirstlane((int)threadIdx.x >> 6);
    const int G = gridDim.x, gw = blockIdx.x * 8 + wave, NGW = G * 8;
    if (threadIdx.x == 0) {
#pragma unroll
        for (int k = 0; k < 23; ++k) ((LAS unsigned long long*)(lds + PTAB_OFF))[k] = (unsigned long long)args.in[k];
    }
    if (threadIdx.x < 2) ((LAS unsigned*)(lds + BARST_OFF))[threadIdx.x] = 0u;
    __syncthreads();
    XcdBarrier xbar = xcd_barrier_post((unsigned*)(args.ws + WS_CTL), (volatile LAS unsigned*)(lds + BARST_OFF));
#define INP(k) ld_ptr(lds, (k))
#define WS_PTRS() size_t wz_ = 0; asm volatile("" : "+s"(wz_)); unsigned char* ws = args.ws + wz_;     \
    bf16_t* WB = (bf16_t*)(ws + WS_W); bf16_t* Z = (bf16_t*)(ws + WS_Z); bf16_t* VT = (bf16_t*)(ws + WS_VT); bf16_t* U = (bf16_t*)(ws + WS_U); \
    bf16_t* F = (bf16_t*)(ws + WS_F); bf16_t* E = (bf16_t*)(ws + WS_E); bf16_t* UP = (bf16_t*)(ws + WS_UP); bf16_t* HB = (bf16_t*)(ws + WS_HB); bf16_t* PB = (bf16_t*)(ws + WS_PLEB); \
    const bf16_t* WL = WB + (size_t)layer * WL_TOTAL; (void)Z; (void)VT; (void)U; (void)F; (void)E; (void)UP; (void)HB; (void)PB; (void)WL;

    {
        const int layer = 0; WS_PTRS();
        LAS float* scr = (LAS float*)(lds + wave * 16640);
        int tid_ = threadIdx.x; asm volatile("" : "+v"(tid_)); const int lane = tid_ & 63;
        int per_layer = 0;
#pragma unroll
        for (int sg_ = 0; sg_ < NSEG; ++sg_) { const Seg q = get_seg(sg_); per_layer += (q.K / 64) * (q.ncols / 64); }
        for (int g = gw; g < DEPTH * per_layer; g += NGW) {
            const int lyr = g / per_layer; int rem = g - lyr * per_layer, si = 0;
#pragma unroll 1
            for (; si < NSEG - 1; ++si) { const Seg q = get_seg(si); const int n = (q.K / 64) * (q.ncols / 64); if (rem < n) break; rem -= n; }
            const Seg sg = get_seg(si);
            const float* W = INP(sg.in) + (size_t)lyr * sg.K * sg.ldw;
            bf16_t* WT = WB + (size_t)lyr * WL_TOTAL + sg.woff;
            const int nbk = sg.ncols / 64;
            transpose_item(W, sg.ldw, sg.col0, sg.K, WT, sg.ldt, sg.drow0, sg.dcol0, scr, rem / nbk, rem % nbk, lane, sg.scale);
        }
    }
    grid.sync();

    for (int grp = 0; grp < 2; ++grp) {
        const int S = grp ? 8192 : 2048;
        float* hbuf = args.out + (size_t)grp * TG * DM;
        { const int layer = 0; WS_PTRS(); row_phase<true, false>(INP(grp), nullptr, nullptr, ws + WS_H16, INP(14), U, gw, NGW); }
        GSYNC();
        for (int layer = 0; layer < DEPTH; ++layer) {
            { WS_PTRS();
              run_gemm_inproj(lds, U, WL + WL_IN, Z, VT); }
            GSYNC();
            { WS_PTRS(); rope_phase(Z, INP(8) + layer * 128, INP(9) + layer * 128, S, gw, NGW, (unsigned*)(ws + WS_CTL) + KMAX_W + grp * 4 + layer, (unsigned*)(ws + WS_CTL) + KCMAX_W + grp * 4 + layer); }
            GSYNC();
            {
                WS_PTRS();
                const int nqb = S / 256, rows = S / 64;
                unsigned* qctr = (unsigned*)(ws + WS_CTL) + QX_W + (grp * 4 + layer) * 8;
                volatile LAS int* slot = (volatile LAS int*)(lds + QSLOT_OFF);
                const int myq = (int)(xbar.x & 7u);
                int qi = 0;
                for (;;) {
                    __syncthreads();
                    if (threadIdx.x == 0) {
                        int got = -1;
                        while (qi < 8) { const int q = (myq + qi) & 7; const unsigned p = __hip_atomic_fetch_add(qctr + q, 1u, __ATOMIC_RELAXED, __HIP_MEMORY_SCOPE_AGENT);
                            if (p < 320u) { got = q * 320 + (int)p; break; } ++qi; }
                        *slot = got;
                    }
                    __syncthreads();
                    const int u = __builtin_amdgcn_readfirstlane(*slot);
                    if (u < 0) break;
                    const int q = u / 320, p = u - q * 320;
                    if (p < 64) {
                        int b, hq, qb;
                        if (grp) { const int set = q >> 1, kvh = set & 1; b = set >> 1; hq = kvh * 4 + (q & 1) * 2 + (p >> 5); qb = p & 31; }
                        else { const int set = 2 * q + (p >> 5), kvh = set & 1, jj = p & 31; b = set >> 1; hq = kvh * 4 + (jj >> 3); qb = jj & 7; }
                        gqa_unit<true>(b, hq, qb, S, Z, VT, lds, (const unsigned*)(ws + WS_CTL) + KCMAX_W + grp * 4 + layer); }
                    else if (p < 192) {
                        const int idx = p - 64; int b, hd, qb;
                        if (grp) { const bool first = idx < 64, heavy_b0 = q >= 4, use_b0 = (first == heavy_b0); b = use_b0 ? 0 : 1; hd = use_b0 ? q : 7 - q; qb = idx & 63; }
                        else { hd = 7 - (idx >> 4); b = (hd - q) & 7; qb = idx & 15; }
                        const unsigned* kw = (const unsigned*)(ws + WS_CTL) + KMAX_W + grp * 4 + layer;
                        da_unit<true>(layer, b, hd, qb, S, Z, VT, INP(5), INP(6), lds, kw); }
                    else { const int i = p - 192, hp = q, rp_ = i % (rows / 2), b = i / (rows / 2); na_unit<true>(layer, b, rp_, hp, S, Z, VT, INP(7), lds); }
                }
                __syncthreads();
            }
            GSYNC();
            { WS_PTRS(); run_gemm_branch(lds, Z, WL + WL_BR); }
            GSYNC();
            { WS_PTRS(); run_gemm<0>(lds, Z + Z_GZ, ZW, WL + WL_O3, DM, TG, DM, DM, F, DM, nullptr, 0); }
            GSYNC();
            { WS_PTRS();
              row_phase<false, false>(ws + WS_H16, F, INP(15) + layer * DM, ws + WS_H16, INP(16) + layer * DM, U, gw, NGW);
              ple_phase(INP(2 + grp) + (size_t)layer * TG * PLED, PB, gw, NGW); }
            GSYNC();
            { WS_PTRS();
              run_gemm<2>(lds, U, DM, WL + WL_UP, DM, TG, DFF, DM, UP, DFF, nullptr, 0);
              run_gemm<0>(lds, PB, PLED, WL + WL_PL, PLED, TG, DM, PLED, E, DM, nullptr, 0); }
            GSYNC();
            { WS_PTRS(); run_gemm<0>(lds, UP, DFF, WL + WL_DN, DFF, TG, DM, DFF, F, DM, nullptr, 0); }
            GSYNC();
            { WS_PTRS(); row_phase<false, false>(ws + WS_H16, F, INP(17) + layer * DM, ws + WS_H16, nullptr, nullptr, gw, NGW); }
            GSYNC();
            { WS_PTRS(); run_gemm<3>(lds, (const bf16_t*)(ws + WS_H16), DM, WL + WL_PG, DM, TG, DM, DM, E, DM, E, DM); }
            GSYNC();
            { WS_PTRS();
              if (layer + 1 < DEPTH) row_phase<false, false>(ws + WS_H16, E, INP(22) + layer * DM, ws + WS_H16, INP(14) + (layer + 1) * DM, U, gw, NGW);
              else row_phase<false, true>(ws + WS_H16, E, INP(22) + layer * DM, hbuf, nullptr, nullptr, gw, NGW); }
            GSYNC();
        }
    }
#undef WS_PTRS
#undef INP
}

extern "C" void kernel_launch(void* const* d_in, const int* in_sizes, int n_in, void* d_out, int out_size, void* d_ws, size_t ws_size, hipStream_t stream) {
    static int grid = 0;
    if (grid == 0) {
        if (n_in != 23 || ws_size < WS_END || out_size != 2 * TG * DM) { fprintf(stderr, "kernel_launch: unexpected problem (n_in %d, ws %zu, out %d)\n", n_in, ws_size, out_size); grid = -1; return; }
        int dev = 0, cus = 0, per_cu = 0;
        (void)hipGetDevice(&dev);
        (void)hipDeviceGetAttribute(&cus, hipDeviceAttributeMultiprocessorCount, dev);
        if (hipFuncSetAttribute((const void*)fwd_megakernel, hipFuncAttributeMaxDynamicSharedMemorySize, LDS_BYTES) != hipSuccess) { fprintf(stderr, "kernel_launch: hipFuncSetAttribute failed\n"); grid = -1; return; }
        if (hipOccupancyMaxActiveBlocksPerMultiprocessor(&per_cu, (const void*)fwd_megakernel, 512, LDS_BYTES) != hipSuccess || per_cu < 1) { fprintf(stderr, "kernel_launch: occupancy query gives %d\n", per_cu); per_cu = 1; }
        (void)hipGetLastError();
        grid = cus * 1;
        if (grid <= 0) { grid = -1; return; }
    }
    if (grid < 0) return;
    (void)hipMemsetAsync((char*)d_ws + WS_CTL, 0, CTL_BYTES, stream);
    Args a{};
    for (int i = 0; i < 23; ++i) a.in[i] = (const float*)d_in[i];
    a.out = (float*)d_out; a.ws = (unsigned char*)d_ws;
    void* kargs[] = {&a};
    hipError_t e = hipLaunchCooperativeKernel((const void*)fwd_megakernel, dim3(grid), dim3(512), kargs, LDS_BYTES, stream);
    if (e != hipSuccess) fprintf(stderr, "kernel_launch: cooperative launch failed: %s (grid %d)\n", hipGetErrorString(e), grid);
}
```

```cpp
#include <hip/hip_runtime.h>
#include <hip/hip_cooperative_groups.h>
#include <cstdio>
#include <cstdint>
namespace cg = cooperative_groups;
#define REP_DA 1
#define REP_GQA 1
#define REP_SYNC 1
#define REP_NA 1

#define LAS __attribute__((address_space(3)))
#define DI __device__ __forceinline__
typedef unsigned short bf16_t;
typedef short bf16x8 __attribute__((ext_vector_type(8)));
typedef short s16x4 __attribute__((ext_vector_type(4)));
typedef float f32x4 __attribute__((ext_vector_type(4)));
typedef float f32x16 __attribute__((ext_vector_type(16)));
typedef unsigned u32x4 __attribute__((ext_vector_type(4)));
typedef unsigned u32x2 __attribute__((ext_vector_type(2)));
typedef float f32x2_t __attribute__((ext_vector_type(2)));
typedef __bf16 bf16x2_t __attribute__((ext_vector_type(2)));

constexpr int DM = 1024, DEPTH = 4, TG = 16384, DFF = 4096, PLED = 256, INW = 10752;
constexpr int ZW = 8448, VW = 2304;
constexpr int Z_QA = 0, Z_KA = 1024, Z_QN = 2048, Z_KN = 3072, Z_QC = 4096, Z_KC = 5120, Z_GZ = 5376;
constexpr int V_A = 0, V_N = 1024, V_C = 2048;
constexpr float EPS = 1e-6f, LOG2E = 1.4426950408889634f;
constexpr size_t WL_IN = 0, WL_BR = WL_IN + (size_t)INW * DM, WL_O3 = WL_BR + (size_t)3072 * DM, WL_UP = WL_O3 + (size_t)DM * 3072,
                 WL_DN = WL_UP + (size_t)DFF * DM, WL_PL = WL_DN + (size_t)DM * DFF, WL_PG = WL_PL + (size_t)DM * PLED, WL_TOTAL = WL_PG + (size_t)DM * DM;
constexpr size_t MiB = 1u << 20;
constexpr size_t WS_W = 0, WS_Z = 208 * MiB, WS_VT = 472 * MiB, WS_U = 544 * MiB, WS_CTL = 576 * MiB, CTL_BYTES = 16384, WS_H16 = 578 * MiB, WS_END = 610 * MiB;
static_assert(WL_TOTAL * 2 * DEPTH <= WS_Z, "weights fit");
static_assert((size_t)TG * ZW * 2 == 264 * MiB && (size_t)VW * TG * 2 == 72 * MiB, "sizes");
constexpr size_t WS_F = WS_VT, WS_E = WS_VT + 32 * MiB, WS_UP = WS_Z, WS_HB = WS_Z + 128 * MiB, WS_PLEB = WS_Z + 160 * MiB;
constexpr int LDS_BYTES = 135168;

DI unsigned cvtpk(float lo, float hi) { f32x2_t v = {lo, hi}; bf16x2_t b = __builtin_convertvector(v, bf16x2_t); return __builtin_bit_cast(unsigned, b); }
DI float bf2f(unsigned short u) { return __builtin_bit_cast(float, (unsigned)u << 16); }
DI float bflo(unsigned u) { return __builtin_bit_cast(float, u << 16); }
DI float bfhi(unsigned u) { return __builtin_bit_cast(float, u & 0xffff0000u); }
DI void swap32(unsigned& a, unsigned& b) { asm volatile("s_nop 1\n\tv_permlane32_swap_b32 %0, %1\n\ts_nop 1" : "+v"(a), "+v"(b)); }
DI float xor32_max(float v) { unsigned a = __builtin_bit_cast(unsigned, v), b = a; swap32(a, b); return fmaxf(__builtin_bit_cast(float, a), __builtin_bit_cast(float, b)); }
DI float xor32_sum(float v) { unsigned a = __builtin_bit_cast(unsigned, v), b = a; swap32(a, b); return __builtin_bit_cast(float, a) + __builtin_bit_cast(float, b); }
template <int CTRL> DI float dpp_sum_step(float v) {
    return v + __builtin_bit_cast(float, __builtin_amdgcn_update_dpp(0, __builtin_bit_cast(int, v), CTRL, 0xF, 0xF, true));
}
DI float wave_sum(float v, int lane) {
    v = dpp_sum_step<0xB1>(v);
    v = dpp_sum_step<0x4E>(v);
    v = dpp_sum_step<0x141>(v);
    v = dpp_sum_step<0x140>(v);
    v += __builtin_bit_cast(float, __builtin_amdgcn_ds_bpermute((lane ^ 16) << 2, __builtin_bit_cast(int, v)));
    return xor32_sum(v);
}
DI float fexp2(float x) { return __builtin_amdgcn_exp2f(x); }
DI float sigmoidf_(float x) { return __builtin_amdgcn_rcpf(1.0f + fexp2(-x * LOG2E)); }

namespace pg8 {
constexpr int BM = 256, BK = 64, HALF = 128, HTB = HALF * BK * 2, STAGE_BYTES = 8 * HTB, NXCD = 8, WGM = 4;
__host__ __device__ __forceinline__ int lds_byte(int r, int c) { const int st = (r >> 4) * 2 + (c >> 5), rr = r & 15, cc = c & 31, ob = rr * 64 + cc * 2; return st * 1024 + (ob ^ (((ob >> 9) & 1) << 5)); }
__host__ __device__ __forceinline__ void stage_rc(int b, int& R, int& C) { const int st = b / 1024, sb = b % 1024, swz = sb ^ (((sb >> 9) & 1) << 5); R = (st >> 1) * 16 + swz / 64; C = (st & 1) * 32 + (swz % 64) / 2; }
__host__ __device__ __forceinline__ int perm32(int rho) { const int n = rho >> 4, i = rho & 15; return 8 * (i >> 2) + 4 * n + (i & 3); }

struct Unit { int pm, pn, sel; };
struct Gemm { const bf16_t* A; const bf16_t* Bt; int M, N, K, lda, ldb, a_shift; size_t a_stride; const bf16_t* A2; const bf16_t* Bt2; };

struct StaticOrder {
    int nM, nN, nwg, G, c;
    __host__ __device__ void init(int M, int N, int G_, int c_) { nM = M / BM; nN = N / BM; nwg = nM * nN; G = G_; c = c_; }
    __host__ __device__ bool next(int i, Unit& u) const { const int L = i * G + c; if (L >= nwg) return false; map(L, u); return true; }
    __host__ __device__ void map(int L, Unit& u) const {
        u.sel = 0;
        int wgid = L; { const int q = nwg / NXCD, r = nwg % NXCD, xcd = wgid % NXCD, off = wgid / NXCD; wgid = (xcd < r ? xcd * (q + 1) : r * (q + 1) + (xcd - r) * q) + off; }
        const int nig = WGM * nN, gid = wgid / nig, fm = gid * WGM, gsz = (nM - fm) < WGM ? (nM - fm) : WGM;
        u.pm = fm + ((wgid % nig) % gsz); u.pn = (wgid % nig) / gsz;
    }
};
struct DualOrder {
    StaticOrder a, b; int G, c;
    __host__ __device__ void init(int M1, int N1, int M2, int N2, int G_, int c_) { a.init(M1, N1, G_, c_); b.init(M2, N2, G_, c_); G = G_; c = c_; }
    __host__ __device__ bool next(int i, Unit& u) const {
        const int L = i * G + c;
        if (L < a.nwg) { a.map(L, u); return true; }
        if (L < a.nwg + b.nwg) { b.map(L - a.nwg, u); u.sel = 1; return true; }
        return false;
    }
};

template <int MODE> struct Epi {
    bf16_t* O; int ldc; const bf16_t* X; int ldx;
    DI void operator()(const f32x4 (&acc)[2][2][4][2], const Unit& u, int wr, int wc, int fr, int fq) const {
        const int row0 = u.pm * BM + wr * 64 + fr, col0 = u.pn * BM + wc * 32 + 8 * fq;
        if (MODE == 4) { if ((u.pn >> 2) != 0) __builtin_amdgcn_fence(__ATOMIC_ACQUIRE, "agent"); }
#pragma unroll
        for (int ai = 0; ai < 2; ++ai)
#pragma unroll
            for (int m = 0; m < 4; ++m) {
                const size_t r = (size_t)(row0 + ai * HALF + m * 16);
#pragma unroll
                for (int bj = 0; bj < 2; ++bj) {
                    const int c = col0 + bj * HALF;
                    f32x4 v0 = acc[ai][bj][m][0], v1 = acc[ai][bj][m][1];
                    if (MODE == 1 || MODE == 3) {
                        const u32x4 xv = *(const u32x4*)(X + r * ldx + c);
                        const float x0 = bflo(xv.x), x1 = bfhi(xv.x), x2 = bflo(xv.y), x3 = bfhi(xv.y), x4 = bflo(xv.z), x5 = bfhi(xv.z), x6 = bflo(xv.w), x7 = bfhi(xv.w);
                        if (MODE == 1) {
                            v0 = (f32x4){v0[0] * sigmoidf_(x0), v0[1] * sigmoidf_(x1), v0[2] * sigmoidf_(x2), v0[3] * sigmoidf_(x3)};
                            v1 = (f32x4){v1[0] * sigmoidf_(x4), v1[1] * sigmoidf_(x5), v1[2] * sigmoidf_(x6), v1[3] * sigmoidf_(x7)};
                        } else {
                            v0 = (f32x4){x0 * sigmoidf_(v0[0]), x1 * sigmoidf_(v0[1]), x2 * sigmoidf_(v0[2]), x3 * sigmoidf_(v0[3])};
                            v1 = (f32x4){x4 * sigmoidf_(v1[0]), x5 * sigmoidf_(v1[1]), x6 * sigmoidf_(v1[2]), x7 * sigmoidf_(v1[3])};
                        }
                    }
                    if (MODE == 4) {
                        const int jgrp = u.pn >> 2;
                        const u32x4 xv = *(const u32x4*)(X + r * ldx + c);
                        v0 = (f32x4){v0[0] * sigmoidf_(bflo(xv.x)), v0[1] * sigmoidf_(bfhi(xv.x)), v0[2] * sigmoidf_(bflo(xv.y)), v0[3] * sigmoidf_(bfhi(xv.y))};
                        v1 = (f32x4){v1[0] * sigmoidf_(bflo(xv.z)), v1[1] * sigmoidf_(bfhi(xv.z)), v1[2] * sigmoidf_(bflo(xv.w)), v1[3] * sigmoidf_(bfhi(xv.w))};
                        bf16_t* op = O + r * ldc + (c - 1024 * jgrp);
                        if (jgrp) { const u32x4 pv = *(const u32x4*)op;
                            v0 = v0 + (f32x4){bflo(pv.x), bfhi(pv.x), bflo(pv.y), bfhi(pv.y)}; v1 = v1 + (f32x4){bflo(pv.z), bfhi(pv.z), bflo(pv.w), bfhi(pv.w)}; }
                        u32x4 w; w.x = cvtpk(v0[0], v0[1]); w.y = cvtpk(v0[2], v0[3]); w.z = cvtpk(v1[0], v1[1]); w.w = cvtpk(v1[2], v1[3]);
                        *(u32x4*)op = w;
                        continue;
                    }
                    if (MODE == 2) {
#pragma unroll
                        for (int e = 0; e < 4; ++e) { const float a = fmaxf(v0[e], 0.f), b = fmaxf(v1[e], 0.f); v0[e] = a * a; v1[e] = b * b; }
                    }
                    u32x4 w; w.x = cvtpk(v0[0], v0[1]); w.y = cvtpk(v0[2], v0[3]); w.z = cvtpk(v1[0], v1[1]); w.w = cvtpk(v1[2], v1[3]);
                    if (MODE == 5 && u.sel) *(u32x4*)((bf16_t*)X + r * ldx + c) = w;
                    else *(u32x4*)(O + r * ldc + c) = w;
                }
            }
    }
};

struct BranchOrder {
    StaticOrder base;
    __host__ __device__ void init(int M, int G_, int c_) { base.init(M, 1024, G_, c_); }
    __host__ __device__ bool next(int i, Unit& u) const {
        const int ti = i / 3, j = i - 3 * ti; Unit t;
        if (!base.next(ti, t)) return false;
        u.pm = t.pm; u.pn = j * 4 + t.pn; u.sel = 0; return true;
    }
};
template <class EpiT, bool ALIGN_EPI, class Sched>
DI void gemm_phase(LAS unsigned char* lds, const Gemm g, const Sched& S, const EpiT& E) {
    int tid_ = threadIdx.x; asm volatile("" : "+v"(tid_));
    const int tid = tid_, wid = __builtin_amdgcn_readfirstlane(tid >> 6), lane = tid & 63, wr = wid >> 2, wc = wid & 3, fr = lane & 15, fq = lane >> 4;
    const int K = g.K, nt = K / BK;
    unsigned voffA[2], voffB[2];
#pragma unroll
    for (int i = 0; i < 2; ++i) { int R, C; stage_rc(tid * 16 + i * 8192, R, C); const int Rb = (R & ~31) + perm32(R & 31);
        voffA[i] = (unsigned)(R * g.lda + C) * 2u; voffB[i] = (unsigned)(Rb * g.ldb + C) * 2u; }
    const size_t kstep = (size_t)(BK * 2);
    const size_t hstepA = (size_t)HALF * g.lda * 2, hstepB = (size_t)HALF * g.ldb * 2;
    const size_t tstepA = 2 * hstepA, tstepB = 2 * hstepB;
    const unsigned ldsw = (unsigned)wid * 1024u;
    const int aoff = lds_byte(wr * 64 + fr, fq * 8), boff = lds_byte(wc * 32 + fr, fq * 8);
#define PG8_SA(b, h) (((b) * 2 + (h)) * HTB)
#define PG8_SB(b, h) ((4 + (b) * 2 + (h)) * HTB)
#define PG8_STAGE(bufoff, gbase, voff) do { _Pragma("unroll") for (int _i = 0; _i < 2; ++_i) \
        __builtin_amdgcn_global_load_lds((const unsigned*)((const char*)(gbase) + (voff)[_i]), (LAS unsigned*)(lds + (bufoff) + ldsw + _i * 8192), 16, 0, 0); } while (0)
#define PG8_LDA(dst, b, h) do { _Pragma("unroll") for (int m = 0; m < 4; ++m) _Pragma("unroll") for (int k = 0; k < 2; ++k) dst[m][k] = *(const LAS bf16x8*)(lds + PG8_SA(b, h) + aoff + m * 2048 + k * 1024); } while (0)
#define PG8_LDB(dst, b, h) do { _Pragma("unroll") for (int n = 0; n < 2; ++n) _Pragma("unroll") for (int k = 0; k < 2; ++k) dst[n][k] = *(const LAS bf16x8*)(lds + PG8_SB(b, h) + boff + n * 2048 + k * 1024); } while (0)
#define PG8_MMA(ai, bj, At, Bt) do { __builtin_amdgcn_s_setprio(1); _Pragma("unroll") for (int m = 0; m < 4; ++m) _Pragma("unroll") for (int n = 0; n < 2; ++n) _Pragma("unroll") for (int k = 0; k < 2; ++k) \
        acc[ai][bj][m][n] = __builtin_amdgcn_mfma_f32_16x16x32_bf16(Bt[n][k], At[m][k], acc[ai][bj][m][n], 0, 0, 0); __builtin_amdgcn_s_setprio(0); } while (0)
#define PG8_WAIT_V(n) asm volatile("s_waitcnt vmcnt(" #n ")" ::: "memory")
#define PG8_WAIT_L(n) asm volatile("s_waitcnt lgkmcnt(" #n ")" ::: "memory")
#define PG8_BAR __builtin_amdgcn_s_barrier()
#define PG8_SCHED __builtin_amdgcn_sched_barrier(0)
#define PG8_AOF(u) ((const char*)((u).sel ? g.A2 : g.A) + (size_t)(u).pm * tstepA + (size_t)((u).pn >> g.a_shift) * g.a_stride)
#define PG8_BOF(u) ((const char*)((u).sel ? g.Bt2 : g.Bt) + (size_t)(u).pn * tstepB)
    Unit cur, nxt; int ui = 0;
    if (!S.next(0, cur)) return;
    f32x4 acc[2][2][4][2];
#pragma unroll
    for (int a = 0; a < 2; ++a)
#pragma unroll
        for (int b = 0; b < 2; ++b)
#pragma unroll
            for (int m = 0; m < 4; ++m)
#pragma unroll
                for (int n = 0; n < 2; ++n) acc[a][b][m][n] = (f32x4){0.f, 0.f, 0.f, 0.f};
    bf16x8 At[4][2], B0[2][2], B1[2][2];
    const char* cA = PG8_AOF(cur); const char* cB = PG8_BOF(cur);
    PG8_STAGE(PG8_SB(0, 0), cB, voffB); PG8_STAGE(PG8_SB(0, 1), cB + hstepB, voffB); PG8_STAGE(PG8_SA(0, 0), cA, voffA); PG8_STAGE(PG8_SA(0, 1), cA + hstepA, voffA);
    if (wr == 1) PG8_BAR;
    PG8_WAIT_V(2); PG8_BAR;
    PG8_STAGE(PG8_SB(1, 0), cB + kstep, voffB); PG8_STAGE(PG8_SA(1, 0), cA + kstep, voffA); PG8_STAGE(PG8_SB(1, 1), cB + hstepB + kstep, voffB);
    PG8_WAIT_V(6); PG8_BAR;
    for (;;) {
        const bool has_next = S.next(ui + 1, nxt);
        const char* nA = has_next ? PG8_AOF(nxt) : cA; const char* nB = has_next ? PG8_BOF(nxt) : cB;
        for (int t = 0; t < nt; t += 2) {
            const bool last = (t == nt - 2);
            const char* a1 = cA + (size_t)(t + 1) * kstep;
            const char* a2 = last ? nA : cA + (size_t)(t + 2) * kstep; const char* b2 = last ? nB : cB + (size_t)(t + 2) * kstep;
            const char* a3 = a2 + kstep; const char* b3 = b2 + kstep;
            PG8_LDB(B0, 0, 0); PG8_LDB(B1, 0, 1); PG8_SCHED; PG8_LDA(At, 0, 0); PG8_STAGE(PG8_SA(1, 1), a1 + hstepA, voffA);
            PG8_WAIT_V(8); PG8_WAIT_L(0); PG8_BAR; PG8_MMA(0, 0, At, B0); PG8_MMA(0, 1, At, B1); PG8_BAR; PG8_SCHED;
            PG8_LDA(At, 0, 1); PG8_STAGE(PG8_SB(0, 0), b2, voffB); PG8_STAGE(PG8_SB(0, 1), b2 + hstepB, voffB); PG8_STAGE(PG8_SA(0, 0), a2, voffA);
            PG8_WAIT_V(8); PG8_WAIT_L(0); PG8_BAR; PG8_MMA(1, 0, At, B0); PG8_MMA(1, 1, At, B1); PG8_BAR; PG8_SCHED;
            PG8_LDB(B0, 1, 0); PG8_LDB(B1, 1, 1); PG8_SCHED; PG8_LDA(At, 1, 0); PG8_STAGE(PG8_SA(0, 1), a2 + hstepA, voffA);
            PG8_WAIT_V(8); PG8_WAIT_L(0); PG8_BAR; PG8_MMA(0, 0, At, B0); PG8_MMA(0, 1, At, B1); PG8_BAR; PG8_SCHED;
            PG8_LDA(At, 1, 1); PG8_STAGE(PG8_SB(1, 0), b3, voffB); PG8_STAGE(PG8_SB(1, 1), b3 + hstepB, voffB); PG8_STAGE(PG8_SA(1, 0), a3, voffA);
            PG8_WAIT_V(8); PG8_WAIT_L(0); PG8_BAR; PG8_MMA(1, 0, At, B0); PG8_MMA(1, 1, At, B1); PG8_BAR; PG8_SCHED;
        }
        if constexpr (ALIGN_EPI) { if (wr == 0) PG8_BAR; }
        E(acc, cur, wr, wc, fr, fq);
        if (!has_next) break;
#pragma unroll
        for (int a = 0; a < 2; ++a)
#pragma unroll
            for (int b = 0; b < 2; ++b)
#pragma unroll
                for (int m = 0; m < 4; ++m)
#pragma unroll
                    for (int n = 0; n < 2; ++n) acc[a][b][m][n] = (f32x4){0.f, 0.f, 0.f, 0.f};
        cur = nxt; cA = nA; cB = nB; ++ui;
        if constexpr (ALIGN_EPI) { if (wr == 1) PG8_BAR; }
    }
    PG8_WAIT_V(0);
    if constexpr (!ALIGN_EPI) { if (wr == 0) PG8_BAR; }
    PG8_BAR;
#undef PG8_SA
#undef PG8_SB
#undef PG8_STAGE
#undef PG8_LDA
#undef PG8_LDB
#undef PG8_MMA
#undef PG8_WAIT_V
#undef PG8_WAIT_L
#undef PG8_BAR
#undef PG8_SCHED
#undef PG8_AOF
#undef PG8_BOF
}
}

template <int MODE>
DI void run_gemm(LAS unsigned char* lds, const bf16_t* A, int lda, const bf16_t* Bt, int ldb, int M, int N, int K, bf16_t* O, int ldc, const bf16_t* X, int ldx,
                 int a_shift = 0, size_t a_stride = 0) {
    pg8::Gemm g{A, Bt, M, N, K, lda, ldb, a_shift, a_stride, A, Bt};
    int G_ = (int)gridDim.x, c_ = (int)blockIdx.x; asm volatile("" : "+s"(G_), "+s"(c_));
    pg8::StaticOrder S; S.init(M, N, G_, c_);
    pg8::Epi<MODE> E{O, ldc, X, ldx};
    pg8::gemm_phase<pg8::Epi<MODE>, true, pg8::StaticOrder>(lds, g, S, E);
    __syncthreads();
}
DI void run_gemm_inproj(LAS unsigned char* lds, const bf16_t* U, const bf16_t* Win, bf16_t* Z, bf16_t* VT) {
    pg8::Gemm g{U, Win, TG, ZW, DM, DM, DM, 0, 0, Win + (size_t)ZW * DM, U};
    int G_ = (int)gridDim.x, c_ = (int)blockIdx.x; asm volatile("" : "+s"(G_), "+s"(c_));
    pg8::DualOrder S; S.init(TG, ZW, VW, TG, G_, c_);
    pg8::Epi<5> E{Z, ZW, VT, TG};
    pg8::gemm_phase<pg8::Epi<5>, true, pg8::DualOrder>(lds, g, S, E);
    __syncthreads();
}
DI void run_gemm_branch(LAS unsigned char* lds, bf16_t* Z, const bf16_t* Wbr) {
    pg8::Gemm g{Z, Wbr, TG, 3072, DM, ZW, DM, 2, (size_t)2048 * 2, Z, Wbr};
    int G_ = (int)gridDim.x, c_ = (int)blockIdx.x; asm volatile("" : "+s"(G_), "+s"(c_));
    pg8::BranchOrder S; S.init(TG, G_, c_);
    pg8::Epi<4> E{Z + Z_GZ, ZW, Z + Z_GZ, ZW};
    pg8::gemm_phase<pg8::Epi<4>, true, pg8::BranchOrder>(lds, g, S, E);
    __syncthreads();
}

DI void transpose_item(const float* W, int ldw, int col0, int K, bf16_t* WT, int ldt, int drow0, int dcol0, LAS float* scr, int kb, int nb, int lane, float sc) {
    const int k0 = 64 * kb, n0 = 64 * nb, c = lane & 15, kr = lane >> 4;
    f32x4 v[16];
    const float* src = W + (size_t)(k0 + kr) * ldw + col0 + n0 + 4 * c;
#pragma unroll
    for (int i = 0; i < 16; ++i) v[i] = *(const f32x4*)(src + (size_t)(4 * i) * ldw);
#pragma unroll
    for (int i = 0; i < 16; ++i) { LAS float* d = scr + (4 * c) * 65 + 4 * i + kr; d[0] = v[i].x; d[65] = v[i].y; d[130] = v[i].z; d[195] = v[i].w; }
    asm volatile("s_waitcnt lgkmcnt(0)" ::: "memory");
    const int ch = lane & 7;
#pragma unroll
    for (int j = 0; j < 8; ++j) { const int n = (lane >> 3) + 8 * j; const LAS float* s = scr + n * 65 + 8 * ch;
        u32x4 o; o.x = cvtpk(s[0] * sc, s[1] * sc); o.y = cvtpk(s[2] * sc, s[3] * sc); o.z = cvtpk(s[4] * sc, s[5] * sc); o.w = cvtpk(s[6] * sc, s[7] * sc);
        *(u32x4*)(WT + (size_t)(drow0 + n0 + n) * ldt + dcol0 + k0 + 8 * ch) = o; }
    asm volatile("s_waitcnt lgkmcnt(0)" ::: "memory");
}

constexpr float QSC64 = 0.125f * LOG2E;
struct Seg { int in, ldw, col0, ncols, K, ldt, drow0, dcol0; size_t woff; float scale; };
DI Seg get_seg(int s) {
    switch (s) {
    case 0:  return Seg{4, INW, 0, 1024, DM, DM, 0, 0, WL_IN, QSC64};
    case 1:  return Seg{4, INW, 1024, 1024, DM, DM, 1024, 0, WL_IN, 1.f};
    case 2:  return Seg{4, INW, 3072, 1024, DM, DM, 2048, 0, WL_IN, QSC64};
    case 3:  return Seg{4, INW, 4096, 1024, DM, DM, 3072, 0, WL_IN, 1.f};
    case 4:  return Seg{4, INW, 6144, 1280, DM, DM, 4096, 0, WL_IN, 1.f};
    case 5:  return Seg{4, INW, 7680, 3072, DM, DM, 5376, 0, WL_IN, 1.f};
    case 6:  return Seg{4, INW, 2048, 1024, DM, DM, 8448, 0, WL_IN, 1.f};
    case 7:  return Seg{4, INW, 5120, 1024, DM, DM, 9472, 0, WL_IN, 1.f};
    case 8:  return Seg{4, INW, 7424, 256, DM, DM, 10496, 0, WL_IN, 1.f};
    case 9:  return Seg{10, DM, 0, DM, DM, DM, 0, 0, WL_BR, 1.f};
    case 10: return Seg{11, DM, 0, DM, DM, DM, 1024, 0, WL_BR, 1.f};
    case 11: return Seg{12, DM, 0, DM, DM, DM, 2048, 0, WL_BR, 1.f};
    case 12: return Seg{13, DM, 0, DM, DM, DM, 0, 0, WL_O3, 1.f};
    case 13: return Seg{18, DFF, 0, DFF, DM, DM, 0, 0, WL_UP, 1.f};
    case 14: return Seg{19, DM, 0, DM, DFF, DFF, 0, 0, WL_DN, 1.f};
    case 15: return Seg{20, DM, 0, DM, PLED, PLED, 0, 0, WL_PL, 1.f};
    default: return Seg{21, DM, 0, DM, DM, DM, 0, 0, WL_PG, 1.f};
    }
}
constexpr int NSEG = 17;

template <bool HIN_F32, bool HOUT_F32>
DI void row_phase(const void* hin_, const bf16_t* F, const float* gpost, void* hout_, const float* gnext, bf16_t* U, int gw, int NGW) {
    int tid_ = threadIdx.x; asm volatile("" : "+v"(tid_)); const int lane = tid_ & 63;
    constexpr int RB = 4;
    for (int m0 = gw; m0 < TG; m0 += RB * NGW) {
        f32x4 v[RB][4]; u32x2 fw[RB][4];
#pragma unroll
        for (int k = 0; k < RB; ++k) {
            const int m = m0 + k * NGW; const bool ok = m < TG; const size_t mm = ok ? m : m0;
            if (HIN_F32) { const f32x4* xr = (const f32x4*)((const float*)hin_ + mm * DM) + lane;
#pragma unroll
                for (int j = 0; j < 4; ++j) v[k][j] = xr[64 * j]; }
            else { const u32x2* xr = (const u32x2*)((const bf16_t*)hin_ + mm * DM) + lane;
#pragma unroll
                for (int j = 0; j < 4; ++j) { const u32x2 w = xr[64 * j]; v[k][j] = (f32x4){bflo(w.x), bfhi(w.x), bflo(w.y), bfhi(w.y)}; } }
            if (F) { const u32x2* fr_ = (const u32x2*)(F + mm * DM) + lane;
#pragma unroll
                for (int j = 0; j < 4; ++j) fw[k][j] = fr_[64 * j]; }
        }
        f32x4 gp[4], gn[4];
        if (F) {
#pragma unroll
            for (int j = 0; j < 4; ++j) gp[j] = *((const f32x4*)gpost + lane + 64 * j);
        }
        if (U) {
#pragma unroll
            for (int j = 0; j < 4; ++j) gn[j] = *((const f32x4*)gnext + lane + 64 * j);
        }
#pragma unroll
        for (int k = 0; k < RB; ++k) {
            const int m = m0 + k * NGW; if (m >= TG) continue;
            if (F) {
                f32x4 f[4]; float ss = 0.f;
#pragma unroll
                for (int j = 0; j < 4; ++j) { const u32x2 w = fw[k][j]; f[j] = (f32x4){bflo(w.x), bfhi(w.x), bflo(w.y), bfhi(w.y)}; ss += (f[j].x * f[j].x + f[j].y * f[j].y) + (f[j].z * f[j].z + f[j].w * f[j].w); }
                const float rs = __builtin_amdgcn_rsqf(wave_sum(ss, lane) * (1.f / DM) + EPS);
#pragma unroll
                for (int j = 0; j < 4; ++j) v[k][j] = v[k][j] + f[j] * rs * gp[j];
            }
            if (HOUT_F32) { f32x4* orow = (f32x4*)((float*)hout_ + (size_t)m * DM) + lane;
#pragma unroll
                for (int j = 0; j < 4; ++j) orow[64 * j] = v[k][j]; }
            else { u32x2* o8 = (u32x2*)((bf16_t*)hout_ + (size_t)m * DM) + lane;
#pragma unroll
                for (int j = 0; j < 4; ++j) o8[64 * j] = (u32x2){cvtpk(v[k][j].x, v[k][j].y), cvtpk(v[k][j].z, v[k][j].w)}; }
            if (U) {
                float ss = 0.f;
#pragma unroll
                for (int j = 0; j < 4; ++j) ss += (v[k][j].x * v[k][j].x + v[k][j].y * v[k][j].y) + (v[k][j].z * v[k][j].z + v[k][j].w * v[k][j].w);
                const float rs = __builtin_amdgcn_rsqf(wave_sum(ss, lane) * (1.f / DM) + EPS);
                u32x2* o8 = (u32x2*)(U + (size_t)m * DM) + lane;
#pragma unroll
                for (int j = 0; j < 4; ++j) { const f32x4 y = v[k][j] * rs * gn[j]; o8[64 * j] = (u32x2){cvtpk(y.x, y.y), cvtpk(y.z, y.w)}; }
            }
        }
    }
}
DI void ple_phase(const float* ple, bf16_t* PB, int gw, int NGW) {
    int tid_ = threadIdx.x; asm volatile("" : "+v"(tid_)); const int lane = tid_ & 63;
    for (int m0 = gw; m0 < TG; m0 += 8 * NGW) {
        f32x4 v[8];
#pragma unroll
        for (int k = 0; k < 8; ++k) { const int m = m0 + k * NGW; const size_t mm = m < TG ? m : m0; v[k] = *((const f32x4*)(ple + mm * PLED) + lane); }
#pragma unroll
        for (int k = 0; k < 8; ++k) { const int m = m0 + k * NGW; if (m < TG) *((u32x2*)(PB + (size_t)m * PLED) + lane) = (u32x2){cvtpk(v[k].x, v[k].y), cvtpk(v[k].z, v[k].w)}; }
    }
}
DI void rope_phase(bf16_t* Z, const float* gq, const float* gk, int S, int gw, int NGW, unsigned* kmax_word, unsigned* kcmax_word) {
    int tid_ = threadIdx.x; asm volatile("" : "+v"(tid_)); const int lane = tid_ & 63;
    const float freq = fexp2(-(float)(lane & 31) * 0.41524101186092029f);
    constexpr float QSC128 = 0.08838834764831845f * LOG2E;
    const float gq0 = gq[2 * lane] * QSC128, gq1 = gq[2 * lane + 1] * QSC128, gk0 = gk[2 * lane], gk1 = gk[2 * lane + 1];
    float kcmax2 = 0.f;
    float kmax2 = 0.f;
    for (int t0 = gw; t0 < TG; t0 += 2 * NGW) {
        unsigned w[2][10]; u32x4 ka[2][2];
#pragma unroll
        for (int k = 0; k < 2; ++k) { const int t = t0 + k * NGW; const size_t tt = t < TG ? t : t0;
            const u32x4* kp_ = (const u32x4*)(Z + tt * ZW + Z_KA) + 2 * lane; ka[k][0] = kp_[0]; ka[k][1] = kp_[1]; }
#pragma unroll
        for (int k = 0; k < 2; ++k) { const int t = t0 + k * NGW; const size_t tt = t < TG ? t : t0;
            const unsigned* base = (const unsigned*)(Z + tt * ZW + Z_QC) + lane;
#pragma unroll
            for (int hh = 0; hh < 10; ++hh) w[k][hh] = base[64 * hh]; }
#pragma unroll
        for (int k = 0; k < 2; ++k) {
            const int t = t0 + k * NGW; if (t >= TG) continue;
            { float ss = 0.f;
#pragma unroll
              for (int e = 0; e < 2; ++e) { const u32x4 x = ka[k][e]; const float a0 = bflo(x.x), a1 = bfhi(x.x), a2 = bflo(x.y), a3 = bfhi(x.y), a4 = bflo(x.z), a5 = bfhi(x.z), a6 = bflo(x.w), a7 = bfhi(x.w);
                  ss += (a0 * a0 + a1 * a1) + (a2 * a2 + a3 * a3) + (a4 * a4 + a5 * a5) + (a6 * a6 + a7 * a7); }
              ss += __builtin_bit_cast(float, __builtin_amdgcn_ds_bpermute((lane ^ 1) << 2, __builtin_bit_cast(int, ss)));
              ss += __builtin_bit_cast(float, __builtin_amdgcn_ds_bpermute((lane ^ 2) << 2, __builtin_bit_cast(int, ss)));
              kmax2 = fmaxf(kmax2, ss); }
            unsigned* base = (unsigned*)(Z + (size_t)t * ZW + Z_QC) + lane;
            const int s = t % S, prow = s >> 6, pcol = s & 63;
            const float ang = (float)(lane < 32 ? prow : pcol) * freq, rev = ang * 0.15915494309189535f;
            const float sn = __builtin_amdgcn_sinf(rev), cs = __builtin_amdgcn_cosf(rev);
#pragma unroll
            for (int hh = 0; hh < 10; ++hh) {
                const float x0 = bflo(w[k][hh]), x1 = bfhi(w[k][hh]);
                const float rs = __builtin_amdgcn_rsqf(wave_sum(x0 * x0 + x1 * x1, lane) * (1.f / 128.f) + EPS);
                const float y0 = x0 * rs * (hh < 8 ? gq0 : gk0), y1 = x1 * rs * (hh < 8 ? gq1 : gk1);
                if (hh >= 8) kcmax2 = fmaxf(kcmax2, wave_sum(y0 * y0 + y1 * y1, lane));
                base[64 * hh] = cvtpk(y0 * cs - y1 * sn, y0 * sn + y1 * cs);
            }
        }
    }
#pragma unroll
    for (int o = 4; o < 32; o <<= 1) kmax2 = fmaxf(kmax2, __builtin_bit_cast(float, __builtin_amdgcn_ds_bpermute((lane ^ o) << 2, __builtin_bit_cast(int, kmax2))));
    kmax2 = xor32_max(kmax2);
    if (lane == 0) (void)__hip_atomic_fetch_max(kmax_word, __builtin_bit_cast(unsigned, kmax2), __ATOMIC_RELAXED, __HIP_MEMORY_SCOPE_AGENT);
    if (lane == 0) (void)__hip_atomic_fetch_max(kcmax_word, __builtin_bit_cast(unsigned, kcmax2), __ATOMIC_RELAXED, __HIP_MEMORY_SCOPE_AGENT);
}

#define MFMA32(a, b, c) __builtin_amdgcn_mfma_f32_32x32x16_bf16((a), (b), (c), 0, 0, 0)
constexpr int AT_KS = 0, AT_VS = 33792, AT_RPB = 33792 + 36864;
constexpr int VSTR_B = 136;

template <int ROWS, int ROWLEN, int N>
DI void tile_gload(u32x4 (&v)[N], const bf16_t* src, unsigned ld, int tid) {
    static_assert(N * 512 * 8 == ROWS * ROWLEN, "tile");
    constexpr int CPR = ROWLEN / 8;
#pragma unroll
    for (int i = 0; i < N; ++i) { const unsigned c = (unsigned)tid + 512u * i, row = c / CPR, ch = c % CPR; const unsigned off = (row * ld + ch * 8u) * 2u; v[i] = *(const u32x4*)((const char*)src + off); }
}
template <int ROWS, int ROWLEN, int N>
DI void tile_sstore(const u32x4 (&v)[N], LAS unsigned char* dst, int tid) {
    constexpr int CPR = ROWLEN / 8, STR = (ROWLEN == 64) ? 136 : (ROWLEN + 8) * 2;
#pragma unroll
    for (int i = 0; i < N; ++i) { const int c = tid + 512 * i, row = c / CPR, ch = c % CPR;
        if (ROWLEN == 64) { *(LAS u32x2*)(dst + row * STR + ch * 16) = (u32x2){v[i].x, v[i].y}; *(LAS u32x2*)(dst + row * STR + ch * 16 + 8) = (u32x2){v[i].z, v[i].w}; }
        else *(LAS u32x4*)(dst + row * STR + ch * 16) = v[i]; }
}
template <int NDS>
DI f32x16 qk_block(const LAS unsigned char* kp, const bf16x8* qf, f32x16 s = (f32x16){}) {
#pragma unroll
    for (int ds = 0; ds < NDS; ++ds) { const bf16x8 a = *(const LAS bf16x8*)(kp + ds * 32); s = MFMA32(a, qf[ds], s); }
    return s;
}
DI bf16x8 pack8(const f32x16& p, int s2) {
    u32x4 w;
    if (s2 == 0) { w.x = cvtpk(p[0], p[1]); w.y = cvtpk(p[2], p[3]); w.z = cvtpk(p[4], p[5]); w.w = cvtpk(p[6], p[7]); }
    else { w.x = cvtpk(p[8], p[9]); w.y = cvtpk(p[10], p[11]); w.z = cvtpk(p[12], p[13]); w.w = cvtpk(p[14], p[15]); }
    return __builtin_bit_cast(bf16x8, w);
}
template <int NDB>
DI void pv_block(f32x16* o, const LAS unsigned char* vp, bf16x8 pf0, bf16x8 pf1) {
#pragma unroll
    for (int db = 0; db < NDB; ++db) {
        const LAS unsigned char* p = vp + db * 32 * VSTR_B;
        const s16x4 lo0 = *(const LAS s16x4*)(p), hi0 = *(const LAS s16x4*)(p + 16), lo1 = *(const LAS s16x4*)(p + 32), hi1 = *(const LAS s16x4*)(p + 48);
        const bf16x8 v0 = __builtin_shufflevector(lo0, hi0, 0, 1, 2, 3, 4, 5, 6, 7), v1 = __builtin_shufflevector(lo1, hi1, 0, 1, 2, 3, 4, 5, 6, 7);
        o[db] = MFMA32(v0, pf0, o[db]); o[db] = MFMA32(v1, pf1, o[db]);
    }
}
DI float max16(const f32x16& s) {
    float a = fmaxf(fmaxf(s[0], s[1]), fmaxf(s[2], s[3])), b = fmaxf(fmaxf(s[4], s[5]), fmaxf(s[6], s[7]));
    float c = fmaxf(fmaxf(s[8], s[9]), fmaxf(s[10], s[11])), d = fmaxf(fmaxf(s[12], s[13]), fmaxf(s[14], s[15]));
    return fmaxf(fmaxf(a, b), fmaxf(c, d));
}
template <int NDB, bool MASKED>
DI void softmax_pv(f32x16& s, float c, float& m, float& l, f32x16* o, const LAS unsigned char* vp) {
    float mx = max16(s) * c; mx = xor32_max(mx);
    const float mn = fmaxf(m, mx);
    const float ms = (MASKED && mn == -INFINITY) ? 0.f : mn;
    const float alpha = fexp2(m - ms);
    float ls = 0.f;
#pragma unroll
    for (int i = 0; i < 16; ++i) { s[i] = fexp2(__builtin_fmaf(s[i], c, -ms)); ls += s[i]; }
    l = l * alpha + ls; m = mn;
    if (__any(alpha != 1.0f)) {
#pragma unroll
        for (int db = 0; db < NDB; ++db) o[db] *= alpha;
    }
    pv_block<NDB>(o, vp, pack8(s, 0), pack8(s, 1));
}
DI void stats_step(const f32x16& s, float& m, float& l) {
    float mx = max16(s); mx = xor32_max(mx);
    const float mn = fmaxf(m, mx);
    float ls = 0.f;
#pragma unroll
    for (int i = 0; i < 16; ++i) ls += fexp2(s[i] - mn);
    l = l * fexp2(m - mn) + ls; m = mn;
}
template <int NDB, bool GAIN>
DI void store_o(const f32x16* o, bf16_t* dst  , float sc, const float* gain, int h) {
#pragma unroll
    for (int db = 0; db < NDB; ++db)
#pragma unroll
        for (int k = 0; k < 4; k += 2) {
            unsigned pa[2], pb[2];
#pragma unroll
            for (int gi = 0; gi < 2; ++gi) {
                const int g = k + gi, d = 32 * db + 8 * g + 4 * h;
                float a = o[db][4 * g] * sc, b = o[db][4 * g + 1] * sc, c = o[db][4 * g + 2] * sc, e = o[db][4 * g + 3] * sc;
                if (GAIN) { const f32x4 gg = *(const f32x4*)(gain + d); a *= gg.x; b *= gg.y; c *= gg.z; e *= gg.w; }
                if (gi == 0) { pa[0] = cvtpk(a, b); pa[1] = cvtpk(c, e); } else { pb[0] = cvtpk(a, b); pb[1] = cvtpk(c, e); }
            }
            swap32(pa[0], pb[0]); swap32(pa[1], pb[1]);
            *(u32x4*)(dst + 32 * db + 8 * (k + h)) = (u32x4){pa[0], pa[1], pb[0], pb[1]};
        }
}

constexpr int DA_KS = 0, DA_VS = 17408, DA_STG = 34816, DA_XO = 36864, DA_XS = 102400;
template <bool st> DI void da_unit(int layer, int b, int hd, int qb, int S, bf16_t* Z, const bf16_t* VT, const float* da_lambda, const float* da_norm, LAS unsigned char* lds, const unsigned* kmax_word) {
    int tid_ = threadIdx.x; asm volatile("" : "+v"(tid_));
    const int tid = tid_, lane = tid & 63, r = lane & 31, h = lane >> 5, wid = __builtin_amdgcn_readfirstlane(tid >> 6);
    const int mp = wid >> 2, wr = wid & 3;
    const int tb = b * S, q0 = qb * 128 + wr * 32, qpos = q0 + r, NT = S / 64;
    bf16_t* qrow = Z + (size_t)(tb + q0 + r) * ZW + Z_QA + hd * 128;
    const float sl = fexp2(-(float)(hd + 1)) * LOG2E;
    bf16x8 qf[4];
    float qn2 = 0.f;
#pragma unroll
    for (int ds = 0; ds < 4; ++ds) { qf[ds] = *(const bf16x8*)(qrow + mp * 64 + 16 * ds + 8 * h);
#pragma unroll
        for (int j = 0; j < 8; ++j) { const float x = bf2f((unsigned short)qf[ds][j]); qn2 += x * x; } }
    qn2 = xor32_sum(qn2);
    float qm = qn2;
#pragma unroll
    for (int o_ = 1; o_ < 32; o_ <<= 1) qm = fmaxf(qm, __builtin_bit_cast(float, __builtin_amdgcn_ds_bpermute((lane ^ o_) << 2, __builtin_bit_cast(int, qm))));
    LAS float* xs = (LAS float*)(lds + DA_XS);
    __syncthreads();
    if (lane == 0) xs[wid] = qm;
    __syncthreads();
    float qb2 = xs[0];
#pragma unroll
    for (int w = 1; w < 8; ++w) qb2 = fmaxf(qb2, xs[w]);
    const float kmax2 = __builtin_bit_cast(float, __hip_atomic_load(kmax_word, __ATOMIC_RELAXED, __HIP_MEMORY_SCOPE_AGENT));
    const float sbnd = __builtin_sqrtf(qb2 * kmax2) * 1.01f;
    const float D = (2.f * sbnd + 150.f) / sl, Q0 = (float)(qb * 128);
    const float lo = __builtin_ceilf((Q0 - 63.f - D) * (1.f / 64.f)), hi = __builtin_floorf((Q0 + 127.f + D) * (1.f / 64.f));
    int t_lo = lo < 0.f ? 0 : (int)lo, t_hi = hi > (float)(NT - 1) ? NT - 1 : (int)hi;
    t_lo = __builtin_amdgcn_readfirstlane(t_lo); t_hi = __builtin_amdgcn_readfirstlane(t_hi);
    const float sq = __builtin_sqrtf(qn2 * kmax2) * 1.01f;
    const float mref = fminf(sq, 100.f - sq);
    const bool fast = sbnd <= 110.f;
    const bf16_t* kt = Z + (size_t)tb * ZW + Z_KA + hd * 128;
    const bf16_t* vt = VT + (size_t)(V_A + hd * 128) * TG + tb;
    LAS unsigned char* KS = lds + DA_KS; LAS unsigned char* VS = lds + DA_VS;
    const LAS unsigned char* kp = KS + r * 272 + (mp * 64 + 8 * h) * 2;
    const LAS unsigned char* vp = VS + r * VSTR_B + 8 * h;
    const float slc = -sl;
    float l = 0.f;
    f32x16 o[4];
#pragma unroll
    for (int db = 0; db < 4; ++db) o[db] = (f32x16){};
    u32x4 kr[2], vr[2];
    tile_gload<64, 128>(kr, kt + (size_t)t_lo * 64 * ZW, ZW, tid); tile_gload<128, 64>(vr, vt + (size_t)t_lo * 64, TG, tid);
    if (fast) {
        const float mrc = -mref;
        tile_sstore<64, 128>(kr, KS, tid); tile_sstore<128, 64>(vr, VS, tid);
        if (t_lo + 1 <= t_hi) { tile_gload<64, 128>(kr, kt + (size_t)(t_lo + 1) * 64 * ZW, ZW, tid); tile_gload<128, 64>(vr, vt + (size_t)(t_lo + 1) * 64, TG, tid); }
        __syncthreads();
        for (int t = t_lo; t <= t_hi; ++t) {
            const int cur = ((t - t_lo) & 1) * DA_STG, nxt = DA_STG - cur;
            if (t + 1 <= t_hi) { tile_sstore<64, 128>(kr, KS + nxt, tid); tile_sstore<128, 64>(vr, VS + nxt, tid); }
            if (t + 2 <= t_hi) { tile_gload<64, 128>(kr, kt + (size_t)(t + 2) * 64 * ZW, ZW, tid); tile_gload<128, 64>(vr, vt + (size_t)(t + 2) * 64, TG, tid); }
            const float base = (float)(qpos - (t * 64 + 4 * h));
            f32x16 ta, tb_;
            const int side = (t * 64 + 63 < q0) ? 1 : ((t * 64 > q0 + 31) ? -1 : 0);
            if (side != 0) {
                const float ssl = (side > 0) ? slc : -slc;
                const float a0 = __builtin_fmaf(base, ssl, mrc), a1 = __builtin_fmaf(base - 32.f, ssl, mrc);
#pragma unroll
                for (int i = 0; i < 16; ++i) { const float ci = (float)((i & 3) + 8 * (i >> 2)); float x0 = __builtin_fmaf(-ssl, ci, a0), x1 = __builtin_fmaf(-ssl, ci, a1); asm volatile("" : "+v"(x0), "+v"(x1));   ta[i] = x0; tb_[i] = x1; }
            } else {
#pragma unroll
                for (int i = 0; i < 16; ++i) { const float ci = (float)((i & 3) + 8 * (i >> 2)); float x0 = __builtin_fmaf(fabsf(base - ci), slc, mrc), x1 = __builtin_fmaf(fabsf(base - 32.f - ci), slc, mrc); asm volatile("" : "+v"(x0), "+v"(x1)); ta[i] = x0; tb_[i] = x1; }
            }
            f32x16 sa = qk_block<4>(kp + cur, qf, ta);
            f32x16 sb_ = qk_block<4>(kp + cur + 32 * 272, qf, tb_);
            float ls = 0.f;
#pragma unroll
            for (int i = 0; i < 16; ++i) { sa[i] = fexp2(sa[i]); ls += sa[i]; }
            pv_block<4>(o, vp + cur, pack8(sa, 0), pack8(sa, 1));
#pragma unroll
            for (int i = 0; i < 16; ++i) { sb_[i] = fexp2(sb_[i]); ls += sb_[i]; }
            l += ls;
            pv_block<4>(o, vp + cur + 64, pack8(sb_, 0), pack8(sb_, 1));
            __syncthreads();
        }
    } else {
        float m = -INFINITY;
        for (int t = t_lo; t <= t_hi; ++t) {
            __syncthreads(); tile_sstore<64, 128>(kr, KS, tid); tile_sstore<128, 64>(vr, VS, tid); __syncthreads();
            if (t + 1 <= t_hi) { tile_gload<64, 128>(kr, kt + (size_t)(t + 1) * 64 * ZW, ZW, tid); tile_gload<128, 64>(vr, vt + (size_t)(t + 1) * 64, TG, tid); }
#pragma unroll 1
            for (int kb = 0; kb < 2; ++kb) {
                const float base = (float)(qpos - (t * 64 + 32 * kb + 4 * h));
                f32x16 ta;
#pragma unroll
                for (int i = 0; i < 16; ++i) ta[i] = fabsf(base - (float)((i & 3) + 8 * (i >> 2))) * slc;
                f32x16 s = qk_block<4>(kp + kb * 32 * 272, qf, ta);
                softmax_pv<4, false>(s, 1.0f, m, l, o, vp + kb * 64);
            }
        }
    }
    l = xor32_sum(l);
    const float* L = da_lambda + layer * 256;
    const float sa_ = wave_sum(L[lane] * L[64 + lane], lane), sb2 = wave_sum(L[128 + lane] * L[192 + lane], lane);
    const float linit = 0.8f - 0.6f * __expf(-0.3f * (float)layer);
    const float lam = __expf(sa_) - __expf(sb2) + linit;
    LAS float* xo = (LAS float*)(lds + DA_XO) + wr * 4096 + lane;
    __syncthreads();
    if (mp == 1) { const float sc1 = lam / l;
#pragma unroll
        for (int db = 0; db < 4; ++db)
#pragma unroll
            for (int i = 0; i < 16; ++i) xo[(db * 16 + i) * 64] = o[db][i] * sc1; }
    __syncthreads();
    if (mp == 0) {
        const float il = 1.0f / l; float ss = 0.f;
#pragma unroll
        for (int db = 0; db < 4; ++db)
#pragma unroll
            for (int i = 0; i < 16; ++i) { const float v = o[db][i] * il - xo[(db * 16 + i) * 64]; o[db][i] = v; ss += v * v; }
        ss = xor32_sum(ss);
        const float rn = __builtin_amdgcn_rsqf(ss * (1.f / 128.f) + EPS) * (1.0f - linit);
        if (st) store_o<4, true>(o, qrow, rn, da_norm + layer * 128, h);
    }
}

template <bool st> DI void gqa_unit(int b, int hq, int qb, int S, bf16_t* Z, const bf16_t* VT, LAS unsigned char* lds, const unsigned* kcmax_word) {
    int tid_ = threadIdx.x; asm volatile("" : "+v"(tid_));
    const int tid = tid_, lane = tid & 63, r = lane & 31, h = lane >> 5, wid = __builtin_amdgcn_readfirstlane(tid >> 6);
    const int tb = b * S, q0 = qb * 256 + wid * 32, NT = S / 64, kvh = hq >> 2;
    bf16_t* qrow = Z + (size_t)(tb + q0 + r) * ZW + Z_QC + hq * 128;
    bf16x8 qf[8];
    float qn2 = 0.f;
#pragma unroll
    for (int ds = 0; ds < 8; ++ds) { qf[ds] = *(const bf16x8*)(qrow + 16 * ds + 8 * h);
#pragma unroll
        for (int j = 0; j < 8; ++j) { const float x = bf2f((unsigned short)qf[ds][j]); qn2 += x * x; } }
    qn2 = xor32_sum(qn2);
    const bf16_t* kt = Z + (size_t)tb * ZW + Z_KC + kvh * 128;
    const bf16_t* vt = VT + (size_t)(V_C + kvh * 128) * TG + tb;
    LAS unsigned char* KS = lds + AT_KS; LAS unsigned char* VS = lds + AT_VS;
    const LAS unsigned char* kp = KS + r * 272 + 16 * h;
    const LAS unsigned char* vp = VS + r * VSTR_B + 8 * h;
    const float kc2 = __builtin_bit_cast(float, __hip_atomic_load(kcmax_word, __ATOMIC_RELAXED, __HIP_MEMORY_SCOPE_AGENT));
    const float sq = __builtin_sqrtf(qn2 * kc2) * 1.01f;
    const float mref = fminf(sq, 100.f - sq);
    const bool fixed_ref = !__any(sq > 110.f);
    __syncthreads();
    LAS int* fx = (LAS int*)(lds + AT_RPB);
    if (tid == 0) *fx = 0;
    __syncthreads();
    if (!fixed_ref && lane == 0) *fx = 1;
    __syncthreads();
    const bool fast = __builtin_amdgcn_readfirstlane(*(volatile LAS int*)fx) == 0;
    float l = 0.f;
    f32x16 o[4];
#pragma unroll
    for (int db = 0; db < 4; ++db) o[db] = (f32x16){};
    u32x4 kr[2], vr[2];
    tile_gload<64, 128>(kr, kt, ZW, tid); tile_gload<128, 64>(vr, vt, TG, tid);
    if (fast) {
        const float mrc = -mref;
        f32x16 cinit;
#pragma unroll
        for (int i = 0; i < 16; ++i) cinit[i] = mrc;
        for (int t = 0; t < NT; ++t) {
            __syncthreads(); tile_sstore<64, 128>(kr, KS, tid); tile_sstore<128, 64>(vr, VS, tid); __syncthreads();
            if (t + 1 < NT) { tile_gload<64, 128>(kr, kt + (size_t)(t + 1) * 64 * ZW, ZW, tid); tile_gload<128, 64>(vr, vt + (size_t)(t + 1) * 64, TG, tid); }
            f32x16 sa = qk_block<8>(kp, qf, cinit);
            f32x16 sb_ = qk_block<8>(kp + 32 * 272, qf, cinit);
            float ls = 0.f;
#pragma unroll
            for (int i = 0; i < 16; ++i) { sa[i] = fexp2(sa[i]); ls += sa[i]; }
            pv_block<4>(o, vp, pack8(sa, 0), pack8(sa, 1));
#pragma unroll
            for (int i = 0; i < 16; ++i) { sb_[i] = fexp2(sb_[i]); ls += sb_[i]; }
            l += ls;
            pv_block<4>(o, vp + 64, pack8(sb_, 0), pack8(sb_, 1));
        }
    } else {
        float m = -INFINITY;
        for (int t = 0; t < NT; ++t) {
            __syncthreads(); tile_sstore<64, 128>(kr, KS, tid); tile_sstore<128, 64>(vr, VS, tid); __syncthreads();
            if (t + 1 < NT) { tile_gload<64, 128>(kr, kt + (size_t)(t + 1) * 64 * ZW, ZW, tid); tile_gload<128, 64>(vr, vt + (size_t)(t + 1) * 64, TG, tid); }
#pragma unroll
            for (int kb = 0; kb < 2; ++kb) {
                f32x16 s = qk_block<8>(kp + kb * 32 * 272, qf);
                softmax_pv<4, false>(s, 1.0f, m, l, o, vp + kb * 64);
            }
        }
    }
    l = xor32_sum(l);
    if (st) store_o<4, false>(o, qrow, 1.0f / l, nullptr, h);
}

template <bool st> DI void na_unit(int layer, int b, int rp_, int hp, int S, bf16_t* Z, const bf16_t* VT, const float* na_rpb, LAS unsigned char* lds) {
    int tid_ = threadIdx.x; asm volatile("" : "+v"(tid_));
    const int tid = tid_, lane = tid & 63, r = lane & 31, h = lane >> 5, wid = __builtin_amdgcn_readfirstlane(tid >> 6);
    const int hl = wid >> 2, rs = (wid >> 1) & 1, half = wid & 1, head = hp * 2 + hl, rows = S / 64, row = 2 * rp_ + rs;
    const int tb = b * S;
    int start = row - 4; start = start < 0 ? 0 : start; start = start > rows - 8 ? rows - 8 : start;
    int j_lo = 2 * rp_ - 4; j_lo = j_lo < 0 ? 0 : j_lo; j_lo = j_lo > rows - 8 ? rows - 8 : j_lo;
    int j_hi = 2 * rp_ + 1 - 4; j_hi = j_hi < 0 ? 0 : j_hi; j_hi = j_hi > rows - 8 ? rows - 8 : j_hi; j_hi += 7;
    LAS unsigned char* KS = lds + AT_KS; LAS unsigned char* VS = lds + AT_VS; LAS float* RP = (LAS float*)(lds + AT_RPB);
    __syncthreads();
    { const float* src = na_rpb + ((size_t)layer * 16 + hp * 2) * 465;
      for (int i = tid; i < 2 * 465; i += 512) RP[i] = src[i] * LOG2E; }
    bf16_t* qrow = Z + (size_t)(tb + row * 64 + half * 32 + r) * ZW + Z_QN + head * 64;
    bf16x8 qf[4];
#pragma unroll
    for (int ds = 0; ds < 4; ++ds) qf[ds] = *(const bf16x8*)(qrow + 16 * ds + 8 * h);
    const bf16_t* kt = Z + (size_t)tb * ZW + Z_KN + hp * 128;
    const bf16_t* vt = VT + (size_t)(V_N + hp * 128) * TG + tb;
    const LAS unsigned char* kp = KS + r * 272 + (hl * 64 + 8 * h) * 2;
    const LAS unsigned char* vp = VS + (hl * 64 + r) * VSTR_B + 8 * h;
    const int cq = 32 * half + r; int cs = cq - 8; cs = cs < 0 ? 0 : cs; cs = cs > 48 ? 48 : cs;
    float m = -INFINITY, l = 0.f;
    f32x16 o[2]; o[0] = (f32x16){}; o[1] = (f32x16){};
    f32x16 mneg[2]; int boff[2][16];
#pragma unroll
    for (int kb = 0; kb < 2; ++kb)
#pragma unroll
        for (int i = 0; i < 16; ++i) {
            const int ck = 32 * kb + (i & 3) + 8 * (i >> 2) + 4 * h;
            int idx = ck - cq + 15; idx = idx < 0 ? 0 : idx; idx = idx > 30 ? 30 : idx;
            boff[kb][i] = idx * 4;
            mneg[kb][i] = ((ck >= cs) && (ck < cs + 16)) ? 0.f : -INFINITY;
        }
    u32x4 kr[2], vr[2];
    tile_gload<64, 128>(kr, kt + (size_t)j_lo * 64 * ZW, ZW, tid); tile_gload<128, 64>(vr, vt + (size_t)j_lo * 64, TG, tid);
    for (int j = j_lo; j <= j_hi; ++j) {
        __syncthreads(); tile_sstore<64, 128>(kr, KS, tid); tile_sstore<128, 64>(vr, VS, tid); __syncthreads();
        if (j + 1 <= j_hi) { tile_gload<64, 128>(kr, kt + (size_t)(j + 1) * 64 * ZW, ZW, tid); tile_gload<128, 64>(vr, vt + (size_t)(j + 1) * 64, TG, tid); }
        if (j < start || j >= start + 8) continue;
        const int dr = j - row + 7;
        const LAS unsigned char* rpb = (const LAS unsigned char*)(RP + hl * 465 + dr * 31);
#pragma unroll
        for (int kb = 0; kb < 2; ++kb) {
            f32x16 s = qk_block<4>(kp + kb * 32 * 272, qf, mneg[kb]);
#pragma unroll
            for (int i = 0; i < 16; ++i) s[i] += *(const LAS float*)(rpb + boff[kb][i]);
            softmax_pv<2, true>(s, 1.0f, m, l, o, vp + kb * 64);
        }
    }
    l = xor32_sum(l);
    if (st) store_o<2, false>(o, qrow, 1.0f / l, nullptr, h);
}


#define GAS __attribute__((address_space(1)))
#define XB_TMO      128
#define XB_XCNT(j)  (256  + 64 * (j))
#define XB_XSUB(j)  (1280 + 64 * (j))
#define XB_XGEN(j)  (2304 + 64 * (j))
#define XB_TOP      3328
#define XB_TOPGEN   3392
#define XCD_BAR_WORDS 3456
#define XB_SPIN_CAP (1u << 18)

__device__ __forceinline__ unsigned xb_ld(unsigned* p)              { return __hip_atomic_load(p, __ATOMIC_RELAXED, __HIP_MEMORY_SCOPE_AGENT); }
__device__ __forceinline__ unsigned xb_add(unsigned* p, unsigned v) { return __hip_atomic_fetch_add(p, v, __ATOMIC_RELAXED, __HIP_MEMORY_SCOPE_AGENT); }
__device__ __forceinline__ unsigned xb_xcc_id() { return (unsigned)__builtin_amdgcn_s_getreg((3 << 11) | 20) & 0xFu; }
#define XB_SPIN(cond, bar) do { unsigned _sp = 0; while (cond) { __builtin_amdgcn_s_sleep(1); \
    if ((++_sp & 255u) == 0u) { if (xb_ld(&(bar)[XB_TMO])) break; if (_sp > XB_SPIN_CAP) { atomicAdd(&(bar)[XB_TMO], 1u); break; } } } } while (0)

struct XcdBarrier {
    unsigned* bar; unsigned x;
    volatile LAS unsigned* st;
};

__device__ __forceinline__ XcdBarrier xcd_barrier_post(unsigned* bar, volatile LAS unsigned* st) {
    XcdBarrier b; b.bar = bar; b.x = xb_xcc_id(); b.st = st;
    if (threadIdx.x == 0) (void)xb_add(&bar[XB_XCNT(b.x)], 1u);
    return b;
}
__device__ __forceinline__ void xcd_barrier_complete(unsigned* bar, unsigned x, unsigned& nloc, unsigned& nx) {
    const unsigned G = gridDim.x * gridDim.y * gridDim.z;
    unsigned sum, cnt, mine, sp = 0u;
    for (;;) {
        sum = 0u; cnt = 0u; mine = 0u;
#pragma unroll
        for (unsigned j = 0; j < 16; ++j) { const unsigned c = xb_ld(&bar[XB_XCNT(j)]); sum += c; cnt += (c > 0u) ? 1u : 0u; mine = (j == x) ? c : mine; }
        if (sum == G) break;
        __builtin_amdgcn_s_sleep(1);
        if ((++sp & 255u) == 0u) { if (xb_ld(&bar[XB_TMO])) break; if (sp > XB_SPIN_CAP) { atomicAdd(&bar[XB_TMO], 1u); break; } }
    }
    nloc = mine > 0u ? mine : 1u; nx = cnt > 0u ? cnt : 1u;
}

__device__ __forceinline__ void xcd_barrier(const XcdBarrier& b) {
    asm volatile("s_waitcnt vmcnt(0)" ::: "memory");
    __syncthreads();
    if (threadIdx.x == 0) {
        unsigned* bar = b.bar;
        __builtin_amdgcn_s_waitcnt(0);
        unsigned nloc = b.st[0], nx = b.st[1];
        if (nloc == 0u) { xcd_barrier_complete(bar, b.x, nloc, nx); b.st[0] = nloc; b.st[1] = nx; }
        const unsigned old = xb_add(&bar[XB_XSUB(b.x)], 1u);
        const unsigned gen = old / nloc;
        if (old + 1u == (gen + 1u) * nloc) {
            __builtin_amdgcn_fence(__ATOMIC_RELEASE, "agent");
            asm volatile("s_waitcnt vmcnt(0)" ::: "memory");
            const unsigned og = xb_add(&bar[XB_TOP], 1u);
            const unsigned tg = og / nx;
            if (og + 1u == (tg + 1u) * nx) xb_add(&bar[XB_TOPGEN], 1u);
            else XB_SPIN(xb_ld(&bar[XB_TOPGEN]) == tg, bar);
            __builtin_amdgcn_fence(__ATOMIC_ACQUIRE, "agent");
            xb_add(&bar[XB_XGEN(b.x)], 1u);
            asm volatile("s_waitcnt vmcnt(0)" ::: "memory");
        } else {
            XB_SPIN(xb_ld(&bar[XB_XGEN(b.x)]) == gen, bar);
            __builtin_amdgcn_fence(__ATOMIC_ACQUIRE, "agent");
            asm volatile("s_waitcnt vmcnt(0)" ::: "memory");
        }
    }
    __syncthreads();
}


constexpr int QX_W = 3700;
constexpr int QCTR_W = 3616;
constexpr int KCMAX_W = 3632;
constexpr int KMAX_W = 3600;
constexpr int PTAB_OFF = 134144, BARST_OFF = PTAB_OFF + 256, QSLOT_OFF = PTAB_OFF + 272;
DI const float* ld_ptr(LAS unsigned char* lds, int k) {
    int off = PTAB_OFF + 8 * k; asm volatile("" : "+v"(off));
    const unsigned long long v = *(volatile LAS unsigned long long*)(lds + off);
    const unsigned lo = __builtin_amdgcn_readfirstlane((unsigned)v), hi = __builtin_amdgcn_readfirstlane((unsigned)(v >> 32));
    return (const float*)(GAS const float*)(((unsigned long long)hi << 32) | lo);
}
struct Args { const float* in[23]; float* out; unsigned char* ws; };

__global__ void __launch_bounds__(512, 2) fwd_megakernel(Args args) {
    extern __shared__ __attribute__((aligned(16))) unsigned char lds_raw[];
    LAS unsigned char* lds = (LAS unsigned char*)lds_raw;
    cg::grid_group grid = cg::this_grid();
#define GSYNC() do { xcd_barrier(xbar); if (REP_SYNC > 1) xcd_barrier(xbar); } while (0)
    const int wave = __builtin_amdgcn_readfirstlane((int)threadIdx.x >> 6);
    const int G = gridDim.x, gw = blockIdx.x * 8 + wave, NGW = G * 8;
    if (threadIdx.x == 0) {
#pragma unroll
        for (int k = 0; k < 23; ++k) ((LAS unsigned long long*)(lds + PTAB_OFF))[k] = (unsigned long long)args.in[k];
    }
    if (threadIdx.x < 2) ((LAS unsigned*)(lds + BARST_OFF))[threadIdx.x] = 0u;
    __syncthreads();
    XcdBarrier xbar = xcd_barrier_post((unsigned*)(args.ws + WS_CTL), (volatile LAS unsigned*)(lds + BARST_OFF));
#define INP(k) ld_ptr(lds, (k))
#define WS_PTRS() size_t wz_ = 0; asm volatile("" : "+s"(wz_)); unsigned char* ws = args.ws + wz_;     \
    bf16_t* WB = (bf16_t*)(ws + WS_W); bf16_t* Z = (bf16_t*)(ws + WS_Z); bf16_t* VT = (bf16_t*)(ws + WS_VT); bf16_t* U = (bf16_t*)(ws + WS_U); \
    bf16_t* F = (bf16_t*)(ws + WS_F); bf16_t* E = (bf16_t*)(ws + WS_E); bf16_t* UP = (bf16_t*)(ws + WS_UP); bf16_t* HB = (bf16_t*)(ws + WS_HB); bf16_t* PB = (bf16_t*)(ws + WS_PLEB); \
    const bf16_t* WL = WB + (size_t)layer * WL_TOTAL; (void)Z; (void)VT; (void)U; (void)F; (void)E; (void)UP; (void)HB; (void)PB; (void)WL;

    {
        const int layer = 0; WS_PTRS();
        LAS float* scr = (LAS float*)(lds + wave * 16640);
        int tid_ = threadIdx.x; asm volatile("" : "+v"(tid_)); const int lane = tid_ & 63;
        int per_layer = 0;
#pragma unroll
        for (int sg_ = 0; sg_ < NSEG; ++sg_) { const Seg q = get_seg(sg_); per_layer += (q.K / 64) * (q.ncols / 64); }
        for (int g = gw; g < DEPTH * per_layer; g += NGW) {
            const int lyr = g / per_layer; int rem = g - lyr * per_layer, si = 0;
#pragma unroll 1
            for (; si < NSEG - 1; ++si) { const Seg q = get_seg(si); const int n = (q.K / 64) * (q.ncols / 64); if (rem < n) break; rem -= n; }
            const Seg sg = get_seg(si);
            const float* W = INP(sg.in) + (size_t)lyr * sg.K * sg.ldw;
            bf16_t* WT = WB + (size_t)lyr * WL_TOTAL + sg.woff;
            const int nbk = sg.ncols / 64;
            transpose_item(W, sg.ldw, sg.col0, sg.K, WT, sg.ldt, sg.drow0, sg.dcol0, scr, rem / nbk, rem % nbk, lane, sg.scale);
        }
    }
    grid.sync();

    for (int grp = 0; grp < 2; ++grp) {
        const int S = grp ? 8192 : 2048;
        float* hbuf = args.out + (size_t)grp * TG * DM;
        { const int layer = 0; WS_PTRS(); row_phase<true, false>(INP(grp), nullptr, nullptr, ws + WS_H16, INP(14), U, gw, NGW); }
        GSYNC();
        for (int layer = 0; layer < DEPTH; ++layer) {
            { WS_PTRS();
              run_gemm_inproj(lds, U, WL + WL_IN, Z, VT); }
            GSYNC();
            { WS_PTRS(); rope_phase(Z, INP(8) + layer * 128, INP(9) + layer * 128, S, gw, NGW, (unsigned*)(ws + WS_CTL) + KMAX_W + grp * 4 + layer, (unsigned*)(ws + WS_CTL) + KCMAX_W + grp * 4 + layer); }
            GSYNC();
            {
                WS_PTRS();
                const int nqb = S / 256, rows = S / 64;
                unsigned* qctr = (unsigned*)(ws + WS_CTL) + QX_W + (grp * 4 + layer) * 8;
                volatile LAS int* slot = (volatile LAS int*)(lds + QSLOT_OFF);
                const int myq = (int)(xbar.x & 7u);
                int qi = 0;
                for (;;) {
                    __syncthreads();
                    if (threadIdx.x == 0) {
                        int got = -1;
                        while (qi < 8) { const int q = (myq + qi) & 7; const unsigned p = __hip_atomic_fetch_add(qctr + q, 1u, __ATOMIC_RELAXED, __HIP_MEMORY_SCOPE_AGENT);
                            if (p < 320u) { got = q * 320 + (int)p; break; } ++qi; }
                        *slot = got;
                    }
                    __syncthreads();
                    const int u = __builtin_amdgcn_readfirstlane(*slot);
                    if (u < 0) break;
                    const int q = u / 320, p = u - q * 320;
                    if (p < 64) {
                        int b, hq, qb;
                        if (grp) { const int set = q >> 1, kvh = set & 1; b = set >> 1; hq = kvh * 4 + (q & 1) * 2 + (p >> 5); qb = p & 31; }
                        else { const int set = 2 * q + (p >> 5), kvh = set & 1, jj = p & 31; b = set >> 1; hq = kvh * 4 + (jj >> 3); qb = jj & 7; }
                        gqa_unit<true>(b, hq, qb, S, Z, VT, lds, (const unsigned*)(ws + WS_CTL) + KCMAX_W + grp * 4 + layer); }
                    else if (p < 192) {
                        const int idx = p - 64; int b, hd, qb;
                        if (grp) { const bool first = idx < 64, heavy_b0 = q >= 4, use_b0 = (first == heavy_b0); b = use_b0 ? 0 : 1; hd = use_b0 ? q : 7 - q; qb = idx & 63; }
                        else { hd = 7 - (idx >> 4); b = (hd - q) & 7; qb = idx & 15; }
                        const unsigned* kw = (const unsigned*)(ws + WS_CTL) + KMAX_W + grp * 4 + layer;
                        da_unit<true>(layer, b, hd, qb, S, Z, VT, INP(5), INP(6), lds, kw); }
                    else { const int i = p - 192, hp = q, rp_ = i % (rows / 2), b = i / (rows / 2); na_unit<true>(layer, b, rp_, hp, S, Z, VT, INP(7), lds); }
                }
                __syncthreads();
            }
            GSYNC();
            { WS_PTRS(); run_gemm_branch(lds, Z, WL + WL_BR); }
            GSYNC();
            { WS_PTRS(); run_gemm<0>(lds, Z + Z_GZ, ZW, WL + WL_O3, DM, TG, DM, DM, F, DM, nullptr, 0); }
            GSYNC();
            { WS_PTRS();
              row_phase<false, false>(ws + WS_H16, F, INP(15) + layer * DM, ws + WS_H16, INP(16) + layer * DM, U, gw, NGW);
              ple_phase(INP(2 + grp) + (size_t)layer * TG * PLED, PB, gw, NGW); }
            GSYNC();
            { WS_PTRS();
              run_gemm<2>(lds, U, DM, WL + WL_UP, DM, TG, DFF, DM, UP, DFF, nullptr, 0);
              run_gemm<0>(lds, PB, PLED, WL + WL_PL, PLED, TG, DM, PLED, E, DM, nullptr, 0); }
            GSYNC();
            { WS_PTRS(); run_gemm<0>(lds, UP, DFF, WL + WL_DN, DFF, TG, DM, DFF, F, DM, nullptr, 0); }
            GSYNC();
            { WS_PTRS(); row_phase<false, false>(ws + WS_H16, F, INP(17) + layer * DM, ws + WS_H16, nullptr, nullptr, gw, NGW); }
            GSYNC();
            { WS_PTRS(); run_gemm<3>(lds, (const bf16_t*)(ws + WS_H16), DM, WL + WL_PG, DM, TG, DM, DM, E, DM, E, DM); }
            GSYNC();
            { WS_PTRS();
              if (layer + 1 < DEPTH) row_phase<false, false>(ws + WS_H16, E, INP(22) + layer * DM, ws + WS_H16, INP(14) + (layer + 1) * DM, U, gw, NGW);
              else row_phase<false, true>(ws + WS_H16, E, INP(22) + layer * DM, hbuf, nullptr, nullptr, gw, NGW); }
            GSYNC();
        }
    }
#undef WS_PTRS
#undef INP
}

extern "C" void kernel_launch(void* const* d_in, const int* in_sizes, int n_in, void* d_out, int out_size, void* d_ws, size_t ws_size, hipStream_t stream) {
    static int grid = 0;
    if (grid == 0) {
        if (n_in != 23 || ws_size < WS_END || out_size != 2 * TG * DM) { fprintf(stderr, "kernel_launch: unexpected problem (n_in %d, ws %zu, out %d)\n", n_in, ws_size, out_size); grid = -1; return; }
        int dev = 0, cus = 0, per_cu = 0;
        (void)hipGetDevice(&dev);
        (void)hipDeviceGetAttribute(&cus, hipDeviceAttributeMultiprocessorCount, dev);
        if (hipFuncSetAttribute((const void*)fwd_megakernel, hipFuncAttributeMaxDynamicSharedMemorySize, LDS_BYTES) != hipSuccess) { fprintf(stderr, "kernel_launch: hipFuncSetAttribute failed\n"); grid = -1; return; }
        if (hipOccupancyMaxActiveBlocksPerMultiprocessor(&per_cu, (const void*)fwd_megakernel, 512, LDS_BYTES) != hipSuccess || per_cu < 1) { fprintf(stderr, "kernel_launch: occupancy query gives %d\n", per_cu); per_cu = 1; }
        (void)hipGetLastError();
        grid = cus * 1;
        if (grid <= 0) { grid = -1; return; }
    }
    if (grid < 0) return;
    (void)hipMemsetAsync((char*)d_ws + WS_CTL, 0, CTL_BYTES, stream);
    Args a{};
    for (int i = 0; i < 23; ++i) a.in[i] = (const float*)d_in[i];
    a.out = (float*)d_out; a.ws = (unsigned char*)d_ws;
    void* kargs[] = {&a};
    hipError_t e = hipLaunchCooperativeKernel((const void*)fwd_megakernel, dim3(grid), dim3(512), kargs, LDS_BYTES, stream);
    if (e != hipSuccess) fprintf(stderr, "kernel_launch: cooperative launch failed: %s (grid %d)\n", hipGetErrorString(e), grid);
}
```
